# Optimizing an MI355X kernel written in HIP

```python
import math
import jax, jax.numpy as jnp
from jax import lax
import numpy as np

D_MODEL = 2048
BATCH = 4
SEQ = 2048
DEPTH = 4

N_MIXERS = 3
MIX_WIDTH = 3 * D_MODEL // 4
MEM_WIDTH = D_MODEL - MIX_WIDTH
MEM_LEN = 256
MEM_HEADS = 4
MEM_HEAD_DIM = MEM_WIDTH // MEM_HEADS

POOL_WINDOWS = (2, 4, 8, 16)
POOL_GROUPS = 4
POOL_GROUP_DIM = MIX_WIDTH // POOL_GROUPS

DIFF_HEAD_DIM = 128
DIFF_HEADS = MIX_WIDTH // (2 * DIFF_HEAD_DIM)
DIFF_V_DIM = 2 * DIFF_HEAD_DIM
ROPE_THETA = 10000.0
Q_BLOCK = 128

SSD_HEAD_DIM = 64
SSD_HEADS = MIX_WIDTH // SSD_HEAD_DIM
SSD_GROUPS = 4
SSD_HEADS_PER_GROUP = SSD_HEADS // SSD_GROUPS
SSD_STATE = 128
SSD_CONV = 4
SSD_CHUNK = 128
SSD_CONV_DIM = MIX_WIDTH + 2 * SSD_GROUPS * SSD_STATE

N_EXPERT_GROUPS = 4
EXPERTS_PER_GROUP = 4
N_EXPERTS = N_EXPERT_GROUPS * EXPERTS_PER_GROUP
TOP_K = 2
D_EXPERT = D_MODEL // 4

RMS_EPS = 1e-6

POOL_IN = MIX_WIDTH + MEM_WIDTH
DIFF_IN = 3 * MIX_WIDTH + MEM_WIDTH
SSD_MIX_IN = MIX_WIDTH + SSD_CONV_DIM + SSD_HEADS
SSD_IN = SSD_MIX_IN + MEM_WIDTH

N_POOL_LAYERS = (DEPTH + 2) // 3
N_DIFF_LAYERS = (DEPTH + 1) // 3
N_SSD_LAYERS = DEPTH // 3

kernel_name = 'hybrid_pool_diffattn_ssd_hmoe'


def rmsnorm(x, g):
    xf = x.astype(jnp.float32)
    y = xf * lax.rsqrt(jnp.mean(xf * xf, axis=-1, keepdims=True) + RMS_EPS)
    return (y * g.astype(jnp.float32)).astype(x.dtype)


def rope_tables(seq, dim):
    pos = jnp.arange(seq, dtype=jnp.float32)
    inv = ROPE_THETA ** (-jnp.arange(0, dim, 2, dtype=jnp.float32) / dim)
    ang = pos[:, None] * inv[None, :]
    ang = jnp.concatenate([ang, ang], axis=-1)
    return jnp.cos(ang), jnp.sin(ang)


def apply_rope(x, cos, sin):
    s, dim = x.shape[1], x.shape[-1]
    shape = (1, s) + (1,) * (x.ndim - 3) + (dim,)
    c, sn = cos.reshape(shape), sin.reshape(shape)
    xf = x.astype(jnp.float32)
    x1, x2 = xf[..., : dim // 2], xf[..., dim // 2:]
    rot = jnp.concatenate([-x2, x1], axis=-1)
    return (xf * c + rot * sn).astype(x.dtype)


def pool_mixer(u, w_grp, scale):
    b, s, _ = u.shape
    ug = u.reshape(b, s, POOL_GROUPS, POOL_GROUP_DIM)
    cs = jnp.cumsum(ug.astype(jnp.float32), axis=1)
    cs = jnp.concatenate([jnp.zeros_like(cs[:, :1]), cs], axis=1)
    t = jnp.arange(s)[:, None]
    win = jnp.array(POOL_WINDOWS, dtype=jnp.int32)[None, :]
    lo = jnp.maximum(t + 1 - win, 0)
    cnt = jnp.minimum(t + 1, win).astype(jnp.float32)
    g_idx = jnp.arange(POOL_GROUPS)[None, :]
    lower = cs[:, lo, g_idx]
    pooled = (cs[:, 1:] - lower) / cnt[None, :, :, None]
    mixed = (pooled - ug.astype(jnp.float32)).astype(u.dtype)
    out = jnp.einsum('bsgc,gcd->bsgd', mixed, w_grp).reshape(b, s, MIX_WIDTH)
    return out * scale


def diff_attention(proj, lam, subln, lambda_init, cos, sin):
    b, s, _ = proj.shape
    q = proj[..., :MIX_WIDTH].reshape(b, s, DIFF_HEADS, 2, DIFF_HEAD_DIM)
    k = proj[..., MIX_WIDTH:2 * MIX_WIDTH].reshape(b, s, DIFF_HEADS, 2, DIFF_HEAD_DIM)
    v = proj[..., 2 * MIX_WIDTH:3 * MIX_WIDTH].reshape(b, s, DIFF_HEADS, DIFF_V_DIM)
    q = apply_rope(q, cos, sin) * (DIFF_HEAD_DIM ** -0.5)
    k = apply_rope(k, cos, sin)
    lf = lam.astype(jnp.float32)
    lmbda = jnp.exp(jnp.sum(lf[0] * lf[1])) - jnp.exp(jnp.sum(lf[2] * lf[3])) + lambda_init
    nb = s // Q_BLOCK
    qb = q.reshape(b, nb, Q_BLOCK, DIFF_HEADS, 2, DIFF_HEAD_DIM).transpose(1, 0, 2, 3, 4, 5)
    k_pos = jnp.arange(s)

    def block(args):
        q_blk, i = args
        q_pos = i * Q_BLOCK + jnp.arange(Q_BLOCK)
        sc = jnp.einsum('bqhcd,bkhcd->bhcqk', q_blk, k).astype(jnp.float32)
        mask = k_pos[None, :] <= q_pos[:, None]
        sc = jnp.where(mask, sc, -jnp.inf)
        p = jax.nn.softmax(sc, axis=-1)
        a = p[:, :, 0] - lmbda * p[:, :, 1]
        return jnp.einsum('bhqk,bkhv->bqhv', a.astype(v.dtype), v)

    o = lax.map(block, (qb, jnp.arange(nb)))
    o = o.transpose(1, 0, 2, 3, 4).reshape(b, s, DIFF_HEADS, DIFF_V_DIM)
    o = rmsnorm(o, subln) * (1.0 - lambda_init)
    return o.reshape(b, s, MIX_WIDTH)


def causal_dwconv(u, w, bias):
    y = lax.conv_general_dilated(u, w[:, None, :], window_strides=(1,),
                                 padding=[(SSD_CONV - 1, 0)],
                                 dimension_numbers=('NWC', 'WIO', 'NWC'),
                                 feature_group_count=u.shape[-1])
    return y + bias


def ssd_scan(x, dt, a, bm, cm):
    b, s, g, hg, p = x.shape
    n = bm.shape[-1]
    nc = s // SSD_CHUNK
    dtg = dt.reshape(b, s, g, hg)
    xc = (x.astype(jnp.float32) * dtg[..., None]).reshape(b, nc, SSD_CHUNK, g, hg, p)
    bc = bm.astype(jnp.float32).reshape(b, nc, SSD_CHUNK, g, n)
    cc = cm.astype(jnp.float32).reshape(b, nc, SSD_CHUNK, g, n)
    ac = (dtg * a.reshape(g, hg)).reshape(b, nc, SSD_CHUNK, g, hg).transpose(0, 3, 4, 1, 2)
    acs = jnp.cumsum(ac, axis=-1)
    seg = acs[..., :, None] - acs[..., None, :]
    causal = jnp.tril(jnp.ones((SSD_CHUNK, SSD_CHUNK), dtype=bool))
    decay = jnp.exp(jnp.where(causal, seg, -jnp.inf))
    scores = jnp.einsum('bclgn,bcsgn->bgcls', cc, bc)
    y_diag = jnp.einsum('bghcls,bcsghp->bclghp', scores[:, :, None] * decay, xc)
    decay_states = jnp.exp(acs[..., -1:] - acs)
    states = jnp.einsum('bcsgn,bghcs,bcsghp->bcghpn', bc, decay_states, xc)
    chunk_decay = jnp.exp(acs[..., -1])

    def step(h, inp):
        st, dec = inp
        return h * dec[..., None, None] + st, h

    h0 = jnp.zeros((b, g, hg, p, n), jnp.float32)
    _, prev = lax.scan(step, h0, (states.transpose(1, 0, 2, 3, 4, 5), chunk_decay.transpose(3, 0, 1, 2)))
    prev = prev.transpose(1, 0, 2, 3, 4, 5)
    y_off = jnp.einsum('bclgn,bcghpn,bghcl->bclghp', cc, prev, jnp.exp(acs))
    return (y_diag + y_off).reshape(b, s, g, hg, p)


def ssd_mixer(proj, conv_w, conv_b, dt_bias, a_log, d_skip, norm_g):
    b, s, _ = proj.shape
    z = proj[..., :MIX_WIDTH]
    xbc = jax.nn.silu(causal_dwconv(proj[..., MIX_WIDTH:MIX_WIDTH + SSD_CONV_DIM], conv_w, conv_b))
    dt_raw = proj[..., MIX_WIDTH + SSD_CONV_DIM:SSD_MIX_IN]
    xs = xbc[..., :MIX_WIDTH].reshape(b, s, SSD_GROUPS, SSD_HEADS_PER_GROUP, SSD_HEAD_DIM)
    bm = xbc[..., MIX_WIDTH:MIX_WIDTH + SSD_GROUPS * SSD_STATE].reshape(b, s, SSD_GROUPS, SSD_STATE)
    cm = xbc[..., MIX_WIDTH + SSD_GROUPS * SSD_STATE:].reshape(b, s, SSD_GROUPS, SSD_STATE)
    dt = jax.nn.softplus(dt_raw.astype(jnp.float32) + dt_bias.astype(jnp.float32))
    a = -jnp.exp(a_log.astype(jnp.float32))
    y = ssd_scan(xs, dt, a, bm, cm)
    y = y + d_skip.astype(jnp.float32).reshape(SSD_GROUPS, SSD_HEADS_PER_GROUP)[..., None] * xs.astype(jnp.float32)
    y = (y.reshape(b, s, MIX_WIDTH) * jax.nn.silu(z.astype(jnp.float32))).astype(proj.dtype)
    y = rmsnorm(y.reshape(b, s, SSD_GROUPS, -1), norm_g.reshape(SSD_GROUPS, -1))
    return y.reshape(b, s, MIX_WIDTH)


def memory_attention(q_proj, mem_kv):
    b, s, _ = q_proj.shape
    m = mem_kv.shape[1]
    q = q_proj.reshape(b, s, MEM_HEADS, MEM_HEAD_DIM) * (MEM_HEAD_DIM ** -0.5)
    k = mem_kv[..., :MEM_WIDTH].reshape(b, m, MEM_HEADS, MEM_HEAD_DIM)
    v = mem_kv[..., MEM_WIDTH:].reshape(b, m, MEM_HEADS, MEM_HEAD_DIM)
    p = jax.nn.softmax(jnp.einsum('bshd,bmhd->bhsm', q, k).astype(jnp.float32), axis=-1)
    o = jnp.einsum('bhsm,bmhd->bshd', p.astype(v.dtype), v)
    return o.reshape(b, s, MEM_WIDTH)


def hier_moe(h, w_group, b_group, w_expert, b_expert, w_gate, w_up, w_down):
    b, s, d = h.shape
    t = h.reshape(b * s, d)
    g_logits = (t @ w_group).astype(jnp.float32) + b_group.astype(jnp.float32)
    g_prob = jax.nn.softmax(g_logits, axis=-1)
    g_sel = jnp.argmax(g_logits, axis=-1)
    g_w = jnp.take_along_axis(g_prob, g_sel[:, None], axis=-1)
    e_logits = ((t @ w_expert).astype(jnp.float32) + b_expert.astype(jnp.float32)).reshape(-1, N_EXPERT_GROUPS, EXPERTS_PER_GROUP)
    e_in = jnp.take_along_axis(e_logits, g_sel[:, None, None], axis=1)[:, 0]
    e_prob = jax.nn.softmax(e_in, axis=-1)
    top_w, top_i = lax.top_k(e_prob, TOP_K)
    top_w = top_w / jnp.sum(top_w, axis=-1, keepdims=True) * g_w
    expert_idx = g_sel[:, None] * EXPERTS_PER_GROUP + top_i
    gates = jnp.sum(jax.nn.one_hot(expert_idx, N_EXPERTS, dtype=jnp.float32) * top_w[..., None], axis=1)
    hid = jax.nn.silu(jnp.einsum('td,edf->tef', t, w_gate)) * jnp.einsum('td,edf->tef', t, w_up)
    hid = (hid * gates[..., None]).astype(h.dtype)
    y = jnp.einsum('tef,efd->td', hid, w_down)
    return y.reshape(b, s, d).astype(h.dtype)


def lambda_init_fn(depth_idx):
    return 0.8 - 0.6 * math.exp(-0.3 * depth_idx)


def setup_inputs(seed: int = 0) -> dict:
    key = jax.random.key(seed)
    ks = jax.random.split(key, 32)

    def nrm(k, shape, scale):
        return jax.random.normal(k, shape, jnp.float32) * scale

    resid = (2.0 * DEPTH) ** -0.5
    dt0 = jnp.exp(jax.random.uniform(ks[19], (N_SSD_LAYERS, SSD_HEADS), jnp.float32, math.log(1e-3), math.log(1e-1)))
    return {
        'x': nrm(ks[0], (BATCH, SEQ, D_MODEL), 1.0),
        'mem': nrm(ks[1], (BATCH, MEM_LEN, D_MODEL), 1.0),
        'norm_mix': 1.0 + nrm(ks[2], (DEPTH, D_MODEL), 0.02),
        'norm_mem': 1.0 + nrm(ks[3], (DEPTH, D_MODEL), 0.02),
        'norm_ffn': 1.0 + nrm(ks[4], (DEPTH, D_MODEL), 0.02),
        'norm_final': 1.0 + nrm(ks[5], (D_MODEL,), 0.02),
        'w_out': nrm(ks[6], (DEPTH, D_MODEL, D_MODEL), D_MODEL ** -0.5 * resid),
        'w_mem_kv': nrm(ks[7], (DEPTH, D_MODEL, 2 * MEM_WIDTH), D_MODEL ** -0.5),
        'pool_w_in': nrm(ks[8], (N_POOL_LAYERS, D_MODEL, POOL_IN), D_MODEL ** -0.5),
        'pool_w_grp': nrm(ks[9], (N_POOL_LAYERS, POOL_GROUPS, POOL_GROUP_DIM, POOL_GROUP_DIM), POOL_GROUP_DIM ** -0.5),
        'pool_scale': 1.0 + nrm(ks[10], (N_POOL_LAYERS, MIX_WIDTH), 0.02),
        'diff_w_in': nrm(ks[11], (N_DIFF_LAYERS, D_MODEL, DIFF_IN), D_MODEL ** -0.5),
        'diff_lambda': nrm(ks[12], (N_DIFF_LAYERS, 4, DIFF_HEAD_DIM), 0.1),
        'diff_subln': 1.0 + nrm(ks[13], (N_DIFF_LAYERS, DIFF_V_DIM), 0.02),
        'ssd_w_in': nrm(ks[14], (N_SSD_LAYERS, D_MODEL, SSD_IN), D_MODEL ** -0.5),
        'ssd_conv_w': nrm(ks[15], (N_SSD_LAYERS, SSD_CONV, SSD_CONV_DIM), SSD_CONV ** -0.5),
        'ssd_conv_b': nrm(ks[16], (N_SSD_LAYERS, SSD_CONV_DIM), 0.01),
        'ssd_dt_bias': dt0 + jnp.log(-jnp.expm1(-dt0)),
        'ssd_a_log': jnp.log(jax.random.uniform(ks[17], (N_SSD_LAYERS, SSD_HEADS), jnp.float32, 1.0, 16.0)),
        'ssd_d': 1.0 + nrm(ks[18], (N_SSD_LAYERS, SSD_HEADS), 0.1),
        'ssd_norm': 1.0 + nrm(ks[20], (N_SSD_LAYERS, MIX_WIDTH), 0.02),
        'moe_w_group': nrm(ks[21], (DEPTH, D_MODEL, N_EXPERT_GROUPS), D_MODEL ** -0.5),
        'moe_b_group': nrm(ks[22], (DEPTH, N_EXPERT_GROUPS), 0.01),
        'moe_w_expert': nrm(ks[23], (DEPTH, D_MODEL, N_EXPERTS), D_MODEL ** -0.5),
        'moe_b_expert': nrm(ks[24], (DEPTH, N_EXPERTS), 0.01),
        'moe_w_gate': nrm(ks[25], (DEPTH, N_EXPERTS, D_MODEL, D_EXPERT), D_MODEL ** -0.5),
        'moe_w_up': nrm(ks[26], (DEPTH, N_EXPERTS, D_MODEL, D_EXPERT), D_MODEL ** -0.5),
        'moe_w_down': nrm(ks[27], (DEPTH, N_EXPERTS, D_EXPERT, D_MODEL), D_EXPERT ** -0.5 * resid),
    }


def reference(x, mem, norm_mix, norm_mem, norm_ffn, norm_final, w_out, w_mem_kv,
              pool_w_in, pool_w_grp, pool_scale, diff_w_in, diff_lambda, diff_subln,
              ssd_w_in, ssd_conv_w, ssd_conv_b, ssd_dt_bias, ssd_a_log, ssd_d, ssd_norm,
              moe_w_group, moe_b_group, moe_w_expert, moe_b_expert, moe_w_gate, moe_w_up, moe_w_down):
    s = x.shape[1]
    cos, sin = rope_tables(s, DIFF_HEAD_DIM)
    for i in range(DEPTH):
        kind, slot = i % N_MIXERS, i // N_MIXERS
        h = rmsnorm(x, norm_mix[i])
        mem_kv = rmsnorm(mem, norm_mem[i]) @ w_mem_kv[i]
        if kind == 0:
            proj = h @ pool_w_in[slot]
            mix = pool_mixer(proj[..., :MIX_WIDTH], pool_w_grp[slot], pool_scale[slot])
        elif kind == 1:
            proj = h @ diff_w_in[slot]
            mix = diff_attention(proj[..., :3 * MIX_WIDTH], diff_lambda[slot], diff_subln[slot],
                                 lambda_init_fn(i), cos, sin)
        else:
            proj = h @ ssd_w_in[slot]
            mix = ssd_mixer(proj[..., :SSD_MIX_IN], ssd_conv_w[slot], ssd_conv_b[slot], ssd_dt_bias[slot],
                            ssd_a_log[slot], ssd_d[slot], ssd_norm[slot])
        mem_out = memory_attention(proj[..., -MEM_WIDTH:], mem_kv)
        x = x + jnp.concatenate([mix, mem_out], axis=-1) @ w_out[i]
        x = x + hier_moe(rmsnorm(x, norm_ffn[i]), moe_w_group[i], moe_b_group[i], moe_w_expert[i],
                         moe_b_expert[i], moe_w_gate[i], moe_w_up[i], moe_w_down[i])
    return rmsnorm(x, norm_final)
```

```cpp
#include <hip/hip_runtime.h>
#include <hip/hip_bf16.h>
#include <cstdio>
#include <cstdint>

namespace pg8 {
#define PG8_LAS __attribute__((address_space(3)))
typedef unsigned short bf16_t;
typedef short bf16x8 __attribute__((ext_vector_type(8)));
typedef float f32x4 __attribute__((ext_vector_type(4)));
typedef unsigned u32x4 __attribute__((ext_vector_type(4)));
constexpr int BM = 256, BK = 64, HALF = 128, HTB = HALF * BK * 2  , STAGE_BYTES = 8 * HTB, NXCD = 8, WGM = 8;

__host__ __device__ __forceinline__ int lds_byte(int r, int c) { const int st = (r >> 4) * 2 + (c >> 5), rr = r & 15, cc = c & 31, ob = rr * 64 + cc * 2; return st * 1024 + (ob ^ (((ob >> 9) & 1) << 5)); }
__host__ __device__ __forceinline__ void stage_rc(int b, int& R, int& C) { const int st = b / 1024, sb = b % 1024, swz = sb ^ (((sb >> 9) & 1) << 5); R = (st >> 1) * 16 + swz / 64; C = (st & 1) * 32 + (swz % 64) / 2; }
__host__ __device__ __forceinline__ int perm32(int rho) { const int n = rho >> 4, i = rho & 15; return 8 * (i >> 2) + 4 * n + (i & 3); }

struct Unit { int pm, pn, om, on, aux; };
struct Gemm { const bf16_t* A; const bf16_t* Bt; int M, N, K; };

struct StaticOrder {
    int nM, nN, nwg, G, c;
    __host__ __device__ void init(int M, int N, int G_, int c_) { nM = M / BM; nN = N / BM; nwg = nM * nN; G = G_; c = c_; }
    __host__ __device__ bool next(int i, Unit& u) const {
        const long L = (long)i * G + c; if (L >= nwg) return false;
        int wgid = (int)L; { const int q = nwg / NXCD, r = nwg % NXCD, xcd = wgid % NXCD, off = wgid / NXCD; wgid = (xcd < r ? xcd * (q + 1) : r * (q + 1) + (xcd - r) * q) + off; }
        const int nig = WGM * nN, gid = wgid / nig, fm = gid * WGM, gsz = (nM - fm) < WGM ? (nM - fm) : WGM;
        u.pm = fm + ((wgid % nig) % gsz); u.pn = (wgid % nig) / gsz; u.om = u.pm; u.on = u.pn; u.aux = 0; return true;
    }
    __device__ __forceinline__ void a_ready(const Unit&) const {}
    __device__ __forceinline__ void done(const Unit&) const {}
};

__device__ __forceinline__ unsigned cvt_pk_bf16(float lo, float hi) { unsigned r; asm volatile("v_cvt_pk_bf16_f32 %0, %1, %2" : "=v"(r) : "v"(lo), "v"(hi)); return r; }


template <bool HAS_ROPE, bool HAS_SCALE> struct EpiStore {
    static constexpr bool PERM = true, AFTER_DRAIN = false;
    bf16_t* O; int ldc; bf16_t* O2; int ldc2; const float* scale; const float* cs; const float* sn;
    __device__ __forceinline__ void operator()(const f32x4 (&acc)[2][2][4][2], const Unit& u, int wr, int wc, int fr, int fq) const {
        bf16_t* base = (u.aux & 4) ? O2 : O; const int ld = (u.aux & 4) ? ldc2 : ldc;
        const int row0 = u.om + wr * 64 + fr;
        if (HAS_ROPE && (u.aux & 1)) {
            const int cl = (wc & 1) * 32 + 8 * fq;
            const int colA = u.on + (wc >> 1) * 128 + cl;
#pragma unroll
            for (int ai = 0; ai < 2; ++ai)
#pragma unroll
                for (int m = 0; m < 4; ++m) {
                    const int row = row0 + ai * HALF + m * 16, pos = row & 2047;
                    const f32x4 c0 = *(const f32x4*)(cs + pos * 64 + cl), c1 = *(const f32x4*)(cs + pos * 64 + cl + 4);
                    const f32x4 s0 = *(const f32x4*)(sn + pos * 64 + cl), s1 = *(const f32x4*)(sn + pos * 64 + cl + 4);
                    const f32x4 l0 = acc[ai][0][m][0], l1 = acc[ai][0][m][1], h0 = acc[ai][1][m][0], h1 = acc[ai][1][m][1];
                    const f32x4 ol0 = l0 * c0 - h0 * s0, ol1 = l1 * c1 - h1 * s1, oh0 = h0 * c0 + l0 * s0, oh1 = h1 * c1 + l1 * s1;
                    bf16_t* rowp = base + (size_t)row * ld + colA;
                    u32x4 w; w.x = cvt_pk_bf16(ol0[0], ol0[1]); w.y = cvt_pk_bf16(ol0[2], ol0[3]); w.z = cvt_pk_bf16(ol1[0], ol1[1]); w.w = cvt_pk_bf16(ol1[2], ol1[3]);
                    *(u32x4*)rowp = w;
                    w.x = cvt_pk_bf16(oh0[0], oh0[1]); w.y = cvt_pk_bf16(oh0[2], oh0[3]); w.z = cvt_pk_bf16(oh1[0], oh1[1]); w.w = cvt_pk_bf16(oh1[2], oh1[3]);
                    *(u32x4*)(rowp + 64) = w;
                    __builtin_amdgcn_sched_barrier(0);
                }
        } else {
            const int col0 = u.on + wc * 32 + 8 * fq;
            f32x4 sv[2][2];
#pragma unroll
            for (int bj = 0; bj < 2; ++bj)
#pragma unroll
                for (int n = 0; n < 2; ++n) sv[bj][n] = (HAS_SCALE && !((u.aux & 2) && bj == 1)) ? *(const f32x4*)(scale + col0 + bj * HALF + 4 * n) : (f32x4){1.f, 1.f, 1.f, 1.f};
#pragma unroll
            for (int ai = 0; ai < 2; ++ai)
#pragma unroll
                for (int m = 0; m < 4; ++m) { bf16_t* rowp = base + (size_t)(row0 + ai * HALF + m * 16) * ld + col0;
#pragma unroll
                    for (int bj = 0; bj < 2; ++bj) { if ((u.aux & 2) && bj == 1) continue;
                        const f32x4 v0 = acc[ai][bj][m][0] * sv[bj][0], v1 = acc[ai][bj][m][1] * sv[bj][1];
                        u32x4 w; w.x = cvt_pk_bf16(v0[0], v0[1]); w.y = cvt_pk_bf16(v0[2], v0[3]); w.z = cvt_pk_bf16(v1[0], v1[1]); w.w = cvt_pk_bf16(v1[2], v1[3]);
                        *(u32x4*)(rowp + bj * HALF) = w; } }
        }
    }
};
struct EpiResid {
    static constexpr bool PERM = false, AFTER_DRAIN = false;
    float* X; int ldc;
    __device__ __forceinline__ void operator()(const f32x4 (&acc)[2][2][4][2], const Unit& u, int wr, int wc, int fr, int fq) const {
        const int row0 = u.om + wr * 64 + fr, col0 = u.on + wc * 32 + 4 * fq;
#pragma unroll
        for (int ai = 0; ai < 2; ++ai)
#pragma unroll
            for (int m = 0; m < 4; ++m) { float* rowp = X + (size_t)(row0 + ai * HALF + m * 16) * ldc + col0;
#pragma unroll
                for (int bj = 0; bj < 2; ++bj)
#pragma unroll
                    for (int n = 0; n < 2; ++n) { f32x4* p = (f32x4*)(rowp + bj * HALF + n * 16); *p = *p + acc[ai][bj][m][n]; } }
    }
};
struct EpiSwiglu {
    static constexpr bool PERM = true, AFTER_DRAIN = false;
    bf16_t* O; int ldc; const float* gw;
    __device__ __forceinline__ void operator()(const f32x4 (&acc)[2][2][4][2], const Unit& u, int wr, int wc, int fr, int fq) const {
        const int row0 = u.om + wr * 64 + fr, col0 = u.on + wc * 32 + 8 * fq;
#pragma unroll
        for (int ai = 0; ai < 2; ++ai)
#pragma unroll
            for (int m = 0; m < 4; ++m) { const int row = row0 + ai * HALF + m * 16; const float g = gw[row];
                f32x4 o[2];
#pragma unroll
                for (int n = 0; n < 2; ++n)
#pragma unroll
                    for (int i = 0; i < 4; ++i) { const float a = acc[ai][0][m][n][i], b = acc[ai][1][m][n][i];
                        const float sg = a * __builtin_amdgcn_rcpf(1.f + __builtin_amdgcn_exp2f(-1.4426950408889634f * a)); o[n][i] = sg * b * g; }
                u32x4 w; w.x = cvt_pk_bf16(o[0][0], o[0][1]); w.y = cvt_pk_bf16(o[0][2], o[0][3]); w.z = cvt_pk_bf16(o[1][0], o[1][1]); w.w = cvt_pk_bf16(o[1][2], o[1][3]);
                *(u32x4*)(O + (size_t)row * ldc + col0) = w; }
    }
};

template <class Epi, class Sched, bool ALIGN_EPI = false, bool SP2 = false>
__device__ __forceinline__ void gemm_phase(PG8_LAS unsigned char* lds, const Gemm g, const Sched& S, const Epi& E, int tid_in) {
    int tid_ = tid_in; asm volatile("" : "+v"(tid_));
    const int tid = tid_, wid = __builtin_amdgcn_readfirstlane(tid >> 6), lane = tid & 63, wr = wid >> 2, wc = wid & 3, fr = lane & 15, fq = lane >> 4;
    const int K = g.K, nt = K / BK;
    unsigned voffA[2], voffB[2];
#pragma unroll
    for (int i = 0; i < 2; ++i) { int R, C; stage_rc(tid * 16 + i * 8192, R, C); const int Rb = Epi::PERM ? ((R & ~31) + perm32(R & 31)) : R;
        voffA[i] = (unsigned)(R * K + C) * 2u; voffB[i] = (unsigned)(Rb * K + C) * 2u; }
    const size_t kstep = (size_t)(BK * 2);
    const size_t hstep = (size_t)HALF * K * 2;
    const size_t tstep = 2 * hstep;
    const unsigned ldsw = (unsigned)wid * 1024u;
    const int aoff = lds_byte(wr * 64 + fr, fq * 8), boff = lds_byte(wc * 32 + fr, fq * 8);
#define PG8_SA(b, h) (((b) * 2 + (h)) * HTB)
#define PG8_SB(b, h) ((4 + (b) * 2 + (h)) * HTB)
#define PG8_STAGE(bufoff, gbase, voff) do { _Pragma("unroll") for (int _i = 0; _i < 2; ++_i) \
        __builtin_amdgcn_global_load_lds((const unsigned*)((const char*)(gbase) + (voff)[_i]), (PG8_LAS unsigned*)(lds + (bufoff) + ldsw + _i * 8192), 16, 0, 0); } while (0)
#define PG8_LDA(dst, b, h) do { _Pragma("unroll") for (int m = 0; m < 4; ++m) _Pragma("unroll") for (int k = 0; k < 2; ++k) dst[m][k] = *(const PG8_LAS bf16x8*)(lds + PG8_SA(b, h) + aoff + m * 2048 + k * 1024); } while (0)
#define PG8_LDB(dst, b, h) do { _Pragma("unroll") for (int n = 0; n < 2; ++n) _Pragma("unroll") for (int k = 0; k < 2; ++k) dst[n][k] = *(const PG8_LAS bf16x8*)(lds + PG8_SB(b, h) + boff + n * 2048 + k * 1024); } while (0)
#define PG8_MMA(ai, bj, At, Bt) do { __builtin_amdgcn_s_setprio(1); _Pragma("unroll") for (int m = 0; m < 4; ++m) _Pragma("unroll") for (int n = 0; n < 2; ++n) _Pragma("unroll") for (int k = 0; k < 2; ++k) \
        acc[ai][bj][m][n] = __builtin_amdgcn_mfma_f32_16x16x32_bf16(Bt[n][k], At[m][k], acc[ai][bj][m][n], 0, 0, 0); __builtin_amdgcn_s_setprio(0); } while (0)
#define PG8_WAIT_V(n) asm volatile("s_waitcnt vmcnt(" #n ")" ::: "memory")
#define PG8_WAIT_L(n) asm volatile("s_waitcnt lgkmcnt(" #n ")" ::: "memory")
#define PG8_BAR __builtin_amdgcn_s_barrier()
#define PG8_SCHED __builtin_amdgcn_sched_barrier(0)
    Unit cur, nxt; int ui = 0;
    if (!S.next(0, cur)) return;
    f32x4 acc[2][2][4][2];
#pragma unroll
    for (int a = 0; a < 2; ++a)
#pragma unroll
        for (int b = 0; b < 2; ++b)
#pragma unroll
            for (int m = 0; m < 4; ++m)
#pragma unroll
                for (int n = 0; n < 2; ++n) acc[a][b][m][n] = (f32x4){0.f, 0.f, 0.f, 0.f};
    bf16x8 At[4][2], B0[2][2], B1[2][2];
    const char* cA = (const char*)g.A + (size_t)cur.pm * tstep; const char* cB = (const char*)g.Bt + (size_t)cur.pn * tstep;
    S.a_ready(cur);
    if constexpr (SP2) {
        PG8_STAGE(PG8_SB(0, 0), cB, voffB); PG8_STAGE(PG8_SB(0, 1), cB + hstep, voffB); PG8_STAGE(PG8_SA(0, 0), cA, voffA); PG8_STAGE(PG8_SA(0, 1), cA + hstep, voffA);
        if (wr == 1) PG8_BAR;
        PG8_WAIT_V(2); PG8_BAR;
        PG8_STAGE(PG8_SB(1, 0), cB + kstep, voffB); PG8_STAGE(PG8_SA(1, 0), cA + kstep, voffA); PG8_STAGE(PG8_SB(1, 1), cB + hstep + kstep, voffB);
        PG8_WAIT_V(6); PG8_BAR;
    } else {
        PG8_STAGE(PG8_SB(0, 0), cB, voffB); PG8_STAGE(PG8_SA(0, 0), cA, voffA); PG8_STAGE(PG8_SB(0, 1), cB + hstep, voffB); PG8_STAGE(PG8_SA(0, 1), cA + hstep, voffA);
        if (wr == 1) PG8_BAR;
        PG8_WAIT_V(4); PG8_BAR;
        PG8_STAGE(PG8_SB(1, 0), cB + kstep, voffB); PG8_STAGE(PG8_SA(1, 0), cA + kstep, voffA); PG8_STAGE(PG8_SB(1, 1), cB + hstep + kstep, voffB);
        PG8_WAIT_V(6); PG8_BAR;
    }
    for (;;) {
        const bool has_next = S.next(ui + 1, nxt);
        const char* nA = has_next ? (const char*)g.A + (size_t)nxt.pm * tstep : cA; const char* nB = has_next ? (const char*)g.Bt + (size_t)nxt.pn * tstep : cB;
        for (int t = 0; t < nt; t += 2) {
            const bool last = (t == nt - 2);
            const char* a1 = cA + (size_t)(t + 1) * kstep;
            const char* a2 = last ? nA : cA + (size_t)(t + 2) * kstep; const char* b2 = last ? nB : cB + (size_t)(t + 2) * kstep;
            const char* a3 = a2 + kstep; const char* b3 = b2 + kstep;
            if (last && has_next) S.a_ready(nxt);
            if constexpr (SP2) {
            PG8_LDB(B0, 0, 0); PG8_LDB(B1, 0, 1); PG8_SCHED; PG8_LDA(At, 0, 0); PG8_STAGE(PG8_SA(1, 1), a1 + hstep, voffA);
            PG8_WAIT_V(8); PG8_WAIT_L(0); PG8_BAR; PG8_MMA(0, 0, At, B0); PG8_MMA(0, 1, At, B1); PG8_BAR; PG8_SCHED;
            PG8_LDA(At, 0, 1); PG8_STAGE(PG8_SB(0, 0), b2, voffB); PG8_STAGE(PG8_SB(0, 1), b2 + hstep, voffB); PG8_STAGE(PG8_SA(0, 0), a2, voffA);
            PG8_WAIT_V(8); PG8_WAIT_L(0); PG8_BAR; PG8_MMA(1, 0, At, B0); PG8_MMA(1, 1, At, B1); PG8_BAR; PG8_SCHED;
            PG8_LDB(B0, 1, 0); PG8_LDB(B1, 1, 1); PG8_SCHED; PG8_LDA(At, 1, 0); PG8_STAGE(PG8_SA(0, 1), a2 + hstep, voffA);
            PG8_WAIT_V(8); PG8_WAIT_L(0); PG8_BAR; PG8_MMA(0, 0, At, B0); PG8_MMA(0, 1, At, B1); PG8_BAR; PG8_SCHED;
            PG8_LDA(At, 1, 1); PG8_STAGE(PG8_SB(1, 0), b3, voffB); PG8_STAGE(PG8_SB(1, 1), b3 + hstep, voffB); PG8_STAGE(PG8_SA(1, 0), a3, voffA);
            PG8_WAIT_V(8); PG8_WAIT_L(0); PG8_BAR; PG8_MMA(1, 0, At, B0); PG8_MMA(1, 1, At, B1); PG8_BAR; PG8_SCHED;
            } else {
            PG8_LDB(B0, 0, 0); PG8_SCHED; PG8_LDA(At, 0, 0); PG8_STAGE(PG8_SA(1, 1), a1 + hstep, voffA);
            PG8_WAIT_L(8); PG8_BAR; PG8_WAIT_L(0); PG8_MMA(0, 0, At, B0); PG8_BAR; PG8_SCHED;
            PG8_LDB(B1, 0, 1); PG8_STAGE(PG8_SB(0, 0), b2, voffB);
            PG8_BAR; PG8_WAIT_L(0); PG8_MMA(0, 1, At, B1); PG8_BAR;
            PG8_LDA(At, 0, 1); PG8_STAGE(PG8_SA(0, 0), a2, voffA);
            PG8_BAR; PG8_WAIT_L(0); PG8_MMA(1, 0, At, B0); PG8_BAR; PG8_SCHED;
            PG8_STAGE(PG8_SB(0, 1), b2 + hstep, voffB);
            PG8_WAIT_V(6); PG8_BAR; PG8_MMA(1, 1, At, B1); PG8_BAR;
            PG8_LDB(B0, 1, 0); PG8_SCHED; PG8_LDA(At, 1, 0); PG8_STAGE(PG8_SA(0, 1), a2 + hstep, voffA);
            PG8_WAIT_L(8); PG8_BAR; PG8_WAIT_L(0); PG8_MMA(0, 0, At, B0); PG8_BAR; PG8_SCHED;
            PG8_LDB(B1, 1, 1); PG8_STAGE(PG8_SB(1, 0), b3, voffB);
            PG8_BAR; PG8_WAIT_L(0); PG8_MMA(0, 1, At, B1); PG8_BAR;
            PG8_LDA(At, 1, 1); PG8_STAGE(PG8_SA(1, 0), a3, voffA);
            PG8_BAR; PG8_WAIT_L(0); PG8_MMA(1, 0, At, B0); PG8_BAR; PG8_SCHED;
            PG8_STAGE(PG8_SB(1, 1), b3 + hstep, voffB);
            PG8_WAIT_V(6); PG8_BAR; PG8_MMA(1, 1, At, B1); PG8_BAR;
            }
        }
        if constexpr (ALIGN_EPI) { if (wr == 0) PG8_BAR; }
        if constexpr (!Epi::AFTER_DRAIN) { E(acc, cur, wr, wc, fr, fq); S.done(cur); }
        if (!has_next) break;
#pragma unroll
        for (int a = 0; a < 2; ++a)
#pragma unroll
            for (int b = 0; b < 2; ++b)
#pragma unroll
                for (int m = 0; m < 4; ++m)
#pragma unroll
                    for (int n = 0; n < 2; ++n) acc[a][b][m][n] = (f32x4){0.f, 0.f, 0.f, 0.f};
        cur = nxt; cA = nA; cB = nB; ++ui;
        if constexpr (ALIGN_EPI) { if (wr == 1) PG8_BAR; }
    }
    PG8_WAIT_V(0);
    if constexpr (!ALIGN_EPI) { if (wr == 0) PG8_BAR; }
    PG8_BAR;
    if constexpr (Epi::AFTER_DRAIN) { E.fused(acc, cur, wr, wc, fr, fq, lds, wid, lane); S.done(cur); }
#undef PG8_SA
#undef PG8_SB
#undef PG8_STAGE
#undef PG8_LDA
#undef PG8_LDB
#undef PG8_MMA
#undef PG8_WAIT_V
#undef PG8_WAIT_L
#undef PG8_BAR
#undef PG8_SCHED
}
}

namespace att {
constexpr int D = 128;
constexpr float THR = 8.f;
constexpr bool WSKIP = false;
constexpr float SCALE = 0.08838834764831845f;
constexpr int NW = 8, QBLK = 32, KVBLK = 64, QB = NW * QBLK;
constexpr int SHM_V = KVBLK * D * 2, SHM_K = KVBLK * D * 2;
constexpr int LDS_BYTES = 2 * SHM_V + 2 * SHM_K + NW * 64 * 4;
using bf16 = __hip_bfloat16;
typedef short bf16x8 __attribute__((ext_vector_type(8)));
typedef short s16x4 __attribute__((ext_vector_type(4)));
typedef float f32x16 __attribute__((ext_vector_type(16)));
typedef float f32x4 __attribute__((ext_vector_type(4)));
typedef unsigned u32x4 __attribute__((ext_vector_type(4)));
template <class A, class Bt> struct same_t { static constexpr bool v = false; };
template <class A> struct same_t<A, A> { static constexpr bool v = true; };

#define KSWZ(row, colB) ((row) * 256 + ((colB) ^ (((row) & 7) << 4)))
#define SBAR() __builtin_amdgcn_sched_barrier(0)
__device__ __forceinline__ int v_st(int k, int c) { const int kk = (k & ~0xC) | ((k & 4) << 1) | ((k & 8) >> 1); return ((kk >> 3) * 4 + (c >> 5)) * 512 + ((kk & 7) * 32 + (c & 31)) * 2; }
__device__ __forceinline__ int v_rd_base(int lane) { return ((lane & 3) << 3) | (((lane >> 2) & 3) << 6) | (((lane >> 4) & 1) << 5) | (((lane >> 5) & 1) << 8); }
constexpr int v_rd_off(int d0, int ks, int half) { return d0 * 512 + ks * 4096 + half * 2048; }
__device__ __forceinline__ int crow(int r, int hi) { return (r & 3) + 8 * (r >> 2) + 4 * hi; }
__device__ __forceinline__ unsigned cvtpk(float lo, float hi) {
    unsigned r; asm volatile("v_cvt_pk_bf16_f32 %0, %1, %2" : "=v"(r) : "v"(lo), "v"(hi)); return r;
}
__device__ __forceinline__ bf16x8 pack8(f32x4 a, f32x4 b) {
    u32x4 w = {cvtpk(a[0], a[1]), cvtpk(a[2], a[3]), cvtpk(b[0], b[1]), cvtpk(b[2], b[3])};
    return *reinterpret_cast<bf16x8*>(&w);
}
template <class T> __device__ __forceinline__ bf16x8 load8(const T* p) {
    if constexpr (same_t<T, float>::v) { return pack8(*(const f32x4*)p, *(const f32x4*)(p + 4)); }
    else { return *reinterpret_cast<const bf16x8*>(p); }
}
__device__ __forceinline__ void mask_tile(f32x16& p0, f32x16& p1, int dq, unsigned W) {
    const float NEG = -__builtin_inff();
#pragma unroll
    for (int r = 0; r < 16; ++r) {
        const int c = (r & 3) + 8 * (r >> 2);
        if ((unsigned)(dq - c) >= W) p0[r] = NEG;
        if ((unsigned)(dq - c - 32) >= W) p1[r] = NEG;
    }
}
__device__ __forceinline__ void partialSM(f32x16& p0, f32x16& p1, float& m_reg, float& mn, float& alpha) {
    float pmax = p0[0]; for (int r = 1; r < 16; ++r) pmax = fmaxf(pmax, p0[r]); for (int r = 0; r < 16; ++r) pmax = fmaxf(pmax, p1[r]);
    { auto rr = __builtin_amdgcn_permlane32_swap(__float_as_uint(pmax), __float_as_uint(pmax), false, false);
      pmax = fmaxf(__uint_as_float(rr[0]), __uint_as_float(rr[1])); }
    constexpr float C2 = 1.4426950408889634f * SCALE;
    if (__builtin_expect(__all((pmax - m_reg) * SCALE <= THR), 1)) { mn = m_reg; alpha = 1.f; }
    else { mn = fmaxf(m_reg, pmax); alpha = __builtin_amdgcn_exp2f((m_reg - mn) * C2); m_reg = mn; }
    const float mnL = -mn * C2;
    for (int r = 0; r < 16; ++r) p0[r] = fmaf(p0[r], C2, mnL); for (int r = 0; r < 16; ++r) p1[r] = fmaf(p1[r], C2, mnL);
    for (int r = 0; r < 16; ++r) p0[r] = __builtin_amdgcn_exp2f(p0[r]);
}
__device__ __forceinline__ void finishSM(f32x16& p0, f32x16& p1, float alpha, float& l_reg, bf16x8& pa0, bf16x8& pa1, bf16x8& pa2, bf16x8& pa3) {
    for (int r = 0; r < 16; ++r) p1[r] = __builtin_amdgcn_exp2f(p1[r]);
    float ps = 0; for (int r = 0; r < 16; ++r) ps += p0[r]; for (int r = 0; r < 16; ++r) ps += p1[r];
    { auto rr = __builtin_amdgcn_permlane32_swap(__float_as_uint(ps), __float_as_uint(ps), false, false);
      ps = __uint_as_float(rr[0]) + __uint_as_float(rr[1]); }
    l_reg = l_reg * alpha + ps;
#define PK4(P, B_, OUT) do { unsigned a0 = cvtpk(P[B_+0], P[B_+1]), a1 = cvtpk(P[B_+2], P[B_+3]);                          \
        unsigned b0 = cvtpk(P[B_+4], P[B_+5]), b1 = cvtpk(P[B_+6], P[B_+7]);                                             \
        auto r0 = __builtin_amdgcn_permlane32_swap(a0, b0, false, false); auto r1 = __builtin_amdgcn_permlane32_swap(a1, b1, false, false); \
        u32x4 w = {r0[0], r1[0], r0[1], r1[1]}; OUT = *reinterpret_cast<bf16x8*>(&w); } while (0)
    PK4(p0, 0, pa0); PK4(p0, 8, pa1); PK4(p1, 0, pa2); PK4(p1, 8, pa3);
#undef PK4
}
template <int KB, bool SK>
__device__ __forceinline__ void qkt(f32x16& p0, f32x16& p1, const char* K_lds, int r32, int hi, const bf16x8* qr, bool act) {
    if (SK && !act) { const float NEG = -__builtin_inff();
#pragma unroll
        for (int r = 0; r < 16; ++r) { p0[r] = NEG; p1[r] = NEG; } return; }
    p0 = f32x16{}; p1 = f32x16{};
    const char* kb[4];
#pragma unroll
    for (int dd = 0; dd < 4; ++dd) kb[dd] = K_lds + KB * SHM_K + KSWZ(r32, (dd * 16 + hi * 8) * 2);
#pragma unroll
    for (int d0 = 0; d0 < 8; ++d0) { const char* a = kb[d0 & 3] + (d0 >> 2) * 128;
        bf16x8 b0 = *reinterpret_cast<const bf16x8*>(a);
        bf16x8 b1 = *reinterpret_cast<const bf16x8*>(a + 32 * 256);
        p0 = __builtin_amdgcn_mfma_f32_32x32x16_bf16(b0, qr[d0], p0, 0, 0, 0);
        p1 = __builtin_amdgcn_mfma_f32_32x32x16_bf16(b1, qr[d0], p1, 0, 0, 0); }
}
template <int VB, bool SK>
__device__ __forceinline__ void pv_tile(f32x16* o, int vb0, bf16x8 pa0, bf16x8 pa1, bf16x8 pa2, bf16x8 pa3, bool act) {
    if (SK && !act) return;
#define TRRD(dst, off) asm volatile("ds_read_b64_tr_b16 %0, %1 offset:%2" : "=&v"(dst) : "v"(vb0), "i"(off) : "memory")
#define PV_D0(d0) do { s16x4 l0, l1, l2, l3, h0, h1, h2, h3; constexpr int b_ = VB * SHM_V + v_rd_off(d0, 0, 0);     \
        TRRD(l0, b_); TRRD(h0, b_ + 2048); TRRD(l1, b_ + 4096); TRRD(h1, b_ + 6144); TRRD(l2, b_ + 8192); TRRD(h2, b_ + 10240); TRRD(l3, b_ + 12288); TRRD(h3, b_ + 14336); \
        asm volatile("s_waitcnt lgkmcnt(0)" ::: "memory"); SBAR();                 \
        o[d0] = __builtin_amdgcn_mfma_f32_32x32x16_bf16(pa0, (bf16x8){l0[0], l0[1], l0[2], l0[3], h0[0], h0[1], h0[2], h0[3]}, o[d0], 0, 0, 0);   \
        o[d0] = __builtin_amdgcn_mfma_f32_32x32x16_bf16(pa1, (bf16x8){l1[0], l1[1], l1[2], l1[3], h1[0], h1[1], h1[2], h1[3]}, o[d0], 0, 0, 0);   \
        o[d0] = __builtin_amdgcn_mfma_f32_32x32x16_bf16(pa2, (bf16x8){l2[0], l2[1], l2[2], l2[3], h2[0], h2[1], h2[2], h2[3]}, o[d0], 0, 0, 0);   \
        o[d0] = __builtin_amdgcn_mfma_f32_32x32x16_bf16(pa3, (bf16x8){l3[0], l3[1], l3[2], l3[3], h3[0], h3[1], h3[2], h3[3]}, o[d0], 0, 0, 0); } while (0)
    PV_D0(0); PV_D0(1); PV_D0(2); PV_D0(3);
#undef PV_D0
#undef TRRD
}

template <class TIn, class TOut> struct BlockRef { const TIn* Q; const TIn* K; const TIn* V; TOut* O; int P0, ldq, ldkv, ldo, skv; };
template <class TIn> struct Seam {
    bf16x8 qr[8];
    bf16x8 st_v0, st_v1, st_k0, st_k1; f32x4 sf0, sf1, sf2, sf3;
    f32x4 tq[16];
};
__device__ __forceinline__ int swa_jlo(int P0, int W) { const int lowk = P0 - W + 1; return lowk > 0 ? lowk / KVBLK : 0; }
#define ROW(p, ld, k0, rr) ((p) + (size_t)((k0) + (rr)) * (ld) + sc)
#define VMW() asm volatile("s_waitcnt vmcnt(0)" ::: "memory")
#define VMWN(n) asm volatile("s_waitcnt vmcnt(%0)" :: "i"(n) : "memory")
#define SLOAD_H(Kp, Vp, ld, k0) do { S.st_v0 = load8<TIn>(ROW(Vp, ld, k0, sr)); S.st_v1 = load8<TIn>(ROW(Vp, ld, k0, 32 + sr));              \
                         S.st_k0 = load8<TIn>(ROW(Kp, ld, k0, sr)); S.st_k1 = load8<TIn>(ROW(Kp, ld, k0, 32 + sr)); } while (0)
#define SWRITE_HK(bf) do { *(bf16x8*)(K_lds + (bf) * SHM_K + kws) = S.st_k0; *(bf16x8*)(K_lds + (bf) * SHM_K + kws + 32 * 256) = S.st_k1; } while (0)
#define SWRITE_HV(bf) do { *(bf16x8*)(V_lds + (bf) * SHM_V + vst0) = S.st_v0; *(bf16x8*)(V_lds + (bf) * SHM_V + vst1) = S.st_v1; } while (0)
#define SWRITE_H(bf) do { SWRITE_HV(bf); SWRITE_HK(bf); } while (0)
#define SLOAD_F(p, ld, k0) do { S.sf0 = *(const f32x4*)ROW(p, ld, k0, sr); S.sf1 = *(const f32x4*)(ROW(p, ld, k0, sr) + 4);                \
                            S.sf2 = *(const f32x4*)ROW(p, ld, k0, 32 + sr); S.sf3 = *(const f32x4*)(ROW(p, ld, k0, 32 + sr) + 4); } while (0)
#define SWRITE_KF(bf) do { *(bf16x8*)(K_lds + (bf) * SHM_K + kws) = pack8(S.sf0, S.sf1); *(bf16x8*)(K_lds + (bf) * SHM_K + kws + 32 * 256) = pack8(S.sf2, S.sf3); } while (0)
#define SWRITE_VF(bf) do { *(bf16x8*)(V_lds + (bf) * SHM_V + vst0) = pack8(S.sf0, S.sf1); *(bf16x8*)(V_lds + (bf) * SHM_V + vst1) = pack8(S.sf2, S.sf3); } while (0)
template <class TIn, class TOut>
__device__ __forceinline__ void causal_swa_prime(const BlockRef<TIn, TOut>& cur, int W, char* lds, Seam<TIn>& S, int tid_in) {
    constexpr bool F32 = same_t<TIn, float>::v;
    int tid_ = tid_in; asm volatile("" : "+v"(tid_));
    const int tid = tid_, wid = __builtin_amdgcn_readfirstlane(tid >> 6), lane = tid & 63, r32 = lane & 31, hi = lane >> 5;
    const int sr = tid >> 4, sc = (tid & 15) * 8, kws = KSWZ(sr, sc * 2); char* K_lds = lds + 2 * SHM_V;
    const int kb0 = swa_jlo(cur.P0, W) * KVBLK;
    for (int d0 = 0; d0 < 8; ++d0) S.qr[d0] = load8<TIn>(cur.Q + (size_t)(wid * QBLK + r32) * cur.ldq + d0 * 16 + hi * 8);
    if constexpr (F32) { SLOAD_F((const float*)cur.K, cur.ldkv, kb0); VMW(); SWRITE_KF(0); SBAR(); SLOAD_F((const float*)cur.V, cur.ldkv, kb0); }
    else { SLOAD_H(cur.K, cur.V, cur.ldkv, kb0); VMW(); SWRITE_HK(0); }
    __syncthreads();
}
template <class TIn, class TOut>
__device__ __forceinline__ void causal_swa_block(const BlockRef<TIn, TOut>& cur, const BlockRef<TIn, TOut>& nxt, int W, char* lds, Seam<TIn>& S, int tid_in) {
    const int skv = cur.skv, ldk = cur.ldkv;
    constexpr bool F32 = same_t<TIn, float>::v;
    int tid_ = tid_in; asm volatile("" : "+v"(tid_));
    const int tid = tid_, wid = __builtin_amdgcn_readfirstlane(tid >> 6), lane = tid & 63, r32 = lane & 31, hi = lane >> 5;
    const int j_lo = swa_jlo(cur.P0, W);
    int j_hi = (cur.P0 + QB - 1) / KVBLK + 1; if (j_hi > skv / KVBLK) j_hi = skv / KVBLK;
    const int NT = j_hi - j_lo;
    const int kbn = swa_jlo(nxt.P0, W) * KVBLK;
    const int qlo = cur.P0 + wid * QBLK, qm = qlo + r32 - 4 * hi;
    char* V_lds = lds; char* K_lds = lds + 2 * SHM_V;
    float* ws = (float*)(lds + 2 * SHM_V + 2 * SHM_K) + wid * 64; float* li_l = ws, * al_l = ws + 32;
    float m_reg = -1e30f, l_reg = 0; f32x16 o[4] = {};
    const int sr = tid >> 4, sc = (tid & 15) * 8, vst0 = v_st(sr, sc), vst1 = v_st(32 + sr, sc), kws = KSWZ(sr, sc * 2);
    const int vb0 = (int)(uintptr_t)V_lds + v_rd_base(lane);
    const TIn* Kh = cur.K; const TIn* Vh = cur.V;
#define RESC(a) do { if (__any((a) < 1.f)) { if (hi == 0) al_l[r32] = (a); asm volatile("s_waitcnt lgkmcnt(0)" ::: "memory");              \
                     for (int d_ = 0; d_ < 4; ++d_) for (int r = 0; r < 16; ++r) o[d_][r] *= al_l[crow(r, hi)]; } } while (0)
#define KBASE(t) ((j_lo + (t)) * KVBLK)
#define ACT(t) (KBASE(t) <= qlo + QBLK - 1 && KBASE(t) + KVBLK - 1 >= qlo - W + 1)
#define MASKT(P0_, P1_, t) do { const int kb_ = KBASE(t); if ((!SK || ACT(t)) && (kb_ + KVBLK - 1 > qlo || kb_ <= qlo + QBLK - 1 - W)) mask_tile(P0_, P1_, qm - kb_, (unsigned)W); } while (0)
    constexpr int NQL = F32 ? 16 : 8;
    constexpr bool SK = WSKIP && !F32;
#define SEAM_K0() do { VMWN(NQL); if constexpr (F32) { SWRITE_KF(0); SBAR(); SLOAD_F((const float*)nxt.V, nxt.ldkv, kbn); } else { SWRITE_HK(0); } SBAR(); } while (0)
    f32x16 pA0, pA1, pB0, pB1; float mnA, mnB, alA, alB; bf16x8 pa0, pa1, pa2, pa3;
    if constexpr (F32) { VMW(); SWRITE_VF(0); SBAR(); } else { SWRITE_HV(0); SBAR(); }
    if (NT > 1) { if constexpr (F32) SLOAD_F((const float*)Kh, ldk, KBASE(1)); else SLOAD_H(Kh, Vh, ldk, KBASE(1)); }
    SBAR(); qkt<0, SK>(pA0, pA1, K_lds, r32, hi, S.qr, ACT(0));
    if constexpr (F32) { if (NT > 1) { VMW(); SWRITE_KF(1); SBAR(); SLOAD_F((const float*)Vh, ldk, KBASE(1)); } }
    MASKT(pA0, pA1, 0); partialSM(pA0, pA1, m_reg, mnA, alA);
    if (NT > 1) { VMW(); if constexpr (F32) { SWRITE_VF(1); SBAR(); if (NT > 2) SLOAD_F((const float*)Kh, ldk, KBASE(2)); } else SWRITE_H(1); }
    __syncthreads();
#define HALF_STEP(PX0, PX1, mnX, alX, PY0, PY1, alY, t, KB, VB, SB) do {                                                      \
        SBAR(); qkt<KB, SK>(PX0, PX1, K_lds, r32, hi, S.qr, ACT(t));                                             \
        finishSM(PY0, PY1, alY, l_reg, pa0, pa1, pa2, pa3); SBAR();                                                           \
        if ((t) + 1 < NT) { if constexpr (F32) { VMW(); SWRITE_KF(SB); SBAR(); SLOAD_F((const float*)Vh, ldk, KBASE((t) + 1)); }  \
                            else { SLOAD_H(Kh, Vh, ldk, KBASE((t) + 1)); } SBAR(); }                                               \
        pv_tile<VB, SK>(o, vb0, pa0, pa1, pa2, pa3, ACT((t) - 1)); MASKT(PX0, PX1, (t)); partialSM(PX0, PX1, m_reg, mnX, alX);                                        \
        __syncthreads();                                                                                                      \
        if ((t) + 1 < NT) { VMW(); if constexpr (F32) { SWRITE_VF(SB); SBAR(); if ((t) + 2 < NT) SLOAD_F((const float*)Kh, ldk, KBASE((t) + 2)); } \
                            else { SWRITE_H(SB); } }                                                                          \
        RESC(alX); __syncthreads(); } while (0)
    for (int t = 1; t + 1 < NT; t += 2) {
        HALF_STEP(pB0, pB1, mnB, alB, pA0, pA1, alA, t, 1, 0, 0);
        HALF_STEP(pA0, pA1, mnA, alA, pB0, pB1, alB, t + 1, 0, 1, 1);
    }
    const bool even = (NT & 1) == 0;
    if (even) { SBAR(); qkt<1, SK>(pB0, pB1, K_lds, r32, hi, S.qr, ACT(NT - 1)); SBAR(); }
#define QROW(e) (nxt.Q + (size_t)(wid * QBLK + r32) * nxt.ldq + ((e) >> 1) * 16 + hi * 8 + ((e) & 1) * 4)
    if constexpr (F32) { SLOAD_F((const float*)nxt.K, nxt.ldkv, kbn); SBAR();
#pragma unroll
        for (int e = 0; e < 8; ++e) S.tq[e] = *(const f32x4*)QROW(e); }
    else { SLOAD_H(nxt.K, nxt.V, nxt.ldkv, kbn); SBAR();
#pragma unroll
        for (int d0 = 0; d0 < 8; ++d0) S.qr[d0] = load8<TIn>(nxt.Q + (size_t)(wid * QBLK + r32) * nxt.ldq + d0 * 16 + hi * 8); }
    SBAR();
    finishSM(pA0, pA1, alA, l_reg, pa0, pa1, pa2, pa3); SBAR();
    if constexpr (F32) {
#pragma unroll
        for (int e = 8; e < 16; ++e) S.tq[e] = *(const f32x4*)QROW(e); SBAR(); }
#undef QROW
    pv_tile<0, SK>(o, vb0, pa0, pa1, pa2, pa3, ACT(even ? NT - 2 : NT - 1));
    if (even) { MASKT(pB0, pB1, NT - 1); partialSM(pB0, pB1, m_reg, mnB, alB); __syncthreads(); RESC(alB);
        finishSM(pB0, pB1, alB, l_reg, pa0, pa1, pa2, pa3); SBAR(); pv_tile<1, SK>(o, vb0, pa0, pa1, pa2, pa3, ACT(NT - 1)); }
    SBAR(); SEAM_K0();
    if (hi == 0) li_l[r32] = l_reg; asm volatile("s_waitcnt lgkmcnt(0)" ::: "memory");
    float rli[16];
#pragma unroll
    for (int r = 0; r < 16; ++r) rli[r] = __builtin_amdgcn_rcpf(li_l[crow(r, hi)]);
    TOut* Ow = cur.O + (size_t)(wid * QBLK) * cur.ldo; const int ldo = cur.ldo;
#pragma unroll
    for (int r = 0; r < 16; ++r) { const int orow = crow(r, hi);
#pragma unroll
        for (int d0 = 0; d0 < 4; ++d0) { const float v = o[d0][r] * rli[r];
            if constexpr (same_t<TOut, float>::v) { Ow[(size_t)orow * ldo + d0 * 32 + r32] = v; }
            else { const float vn = __builtin_bit_cast(float, __builtin_amdgcn_mov_dpp(__builtin_bit_cast(int, v), 0xB1, 0xF, 0xF, true));
                   if ((r32 & 1) == 0) *(unsigned*)(Ow + (size_t)orow * ldo + d0 * 32 + r32) = cvtpk(v, vn); } } }
    if constexpr (F32) {
#pragma unroll
        for (int d0 = 0; d0 < 8; ++d0) S.qr[d0] = pack8(S.tq[2 * d0], S.tq[2 * d0 + 1]); }
    __syncthreads();
#undef RESC
#undef KBASE
#undef ACT
#undef MASKT
#undef SEAM_K0
#undef HALF_STEP
}
#undef ROW
#undef VMW
#undef VMWN
#undef SLOAD_H
#undef SWRITE_HK
#undef SWRITE_HV
#undef SWRITE_H
#undef SLOAD_F
#undef SWRITE_KF
#undef SWRITE_VF

}

#ifndef DBG_CHECKS
#define DBG_CHECKS 0
#endif
#ifndef ABL_NOMOE
#define ABL_NOMOE 0
#endif
#ifndef ABL_SSD
#define ABL_SSD 0
#endif
#ifndef ABL_NOMIX
#define ABL_NOMIX -1
#endif
constexpr int NWAVES = 8;
constexpr int BATCH = 4, SEQ = 2048, T = BATCH * SEQ, DM = 2048, MIXW = 1536, MEMW = 512, MEML = 256, NLAYER = 4;
constexpr int NE = 16, DE = 512, SLOTS = 20480;
constexpr int DTW = 24;
constexpr float RMS_EPS = 1e-6f;

constexpr size_t MiB = 1u << 20, KiB = 1u << 10;
constexpr size_t WS_CTL = 0, CTL_ZERO_BYTES = 1 * MiB;
constexpr size_t WS_COS = 1 * MiB, WS_SIN = WS_COS + 512 * KiB;
constexpr size_t WS_WRT = 2 * MiB;
constexpr size_t WS_WDT = WS_WRT + 640 * KiB;
constexpr size_t WS_SLOT = 3 * MiB;
constexpr size_t WS_ASG = WS_SLOT + 64 * KiB;
constexpr size_t WS_ASGW = WS_ASG + 128 * KiB;
constexpr size_t WS_GWS = WS_ASGW + 64 * KiB;
constexpr size_t WS_DT = 4 * MiB;
constexpr size_t WS_WOUT = 5 * MiB;
constexpr size_t WS_WIN0 = 37 * MiB;
constexpr size_t WS_WMKV = 45 * MiB;
constexpr size_t WS_WIN1 = 61 * MiB;
constexpr size_t WS_WIN2 = 81 * MiB;
constexpr size_t WS_WIN3 = 99 * MiB;
constexpr size_t WS_WGRP = 107 * MiB;
constexpr size_t WS_WGU = 110 * MiB;
constexpr size_t WS_WD = 366 * MiB;
constexpr size_t WS_X = 494 * MiB;
constexpr size_t WS_H = 558 * MiB;
constexpr size_t WS_MEMN = 590 * MiB;
constexpr size_t WS_MEMKV = 606 * MiB;
constexpr size_t WS_BIG = 614 * MiB;
constexpr size_t WS_CONCAT = 694 * MiB;
constexpr size_t WS_OATT = 726 * MiB;
constexpr size_t WS_HIDS = 774 * MiB;
constexpr size_t WS_MIX = 794 * MiB;
constexpr size_t WS_END = 818 * MiB;
static_assert(WS_WMKV == WS_WIN0 + (size_t)2048 * 2048 * 2 && WS_MEMN == WS_H + (size_t)T * DM * 2, "stacked GEMM operands must be contiguous");
constexpr int CW_TMO = 0, CW_CODE = 1;
constexpr int CW_BAR = 4096;
constexpr int CW_CNT = 8192;
constexpr int CW_DBG = 12288;
constexpr int CW_Q = 9216;

constexpr int RING_OFF = 0, RING_BYTES = 131072;
constexpr int LDSCTL_OFF = RING_BYTES, MISC_OFF = LDSCTL_OFF + 320;
constexpr int LDS_BYTES = 147456;

#define GAS __attribute__((address_space(1)))
#define LAS __attribute__((address_space(3)))
typedef unsigned short bf16;
typedef unsigned v4u __attribute__((ext_vector_type(4)));
typedef unsigned v2u __attribute__((ext_vector_type(2)));
typedef int v4i __attribute__((ext_vector_type(4)));
typedef float f32x4 __attribute__((ext_vector_type(4)));
typedef float f32x2 __attribute__((ext_vector_type(2)));
typedef GAS unsigned gu32;
#define RLX_AGENT __ATOMIC_RELAXED, __HIP_MEMORY_SCOPE_AGENT
#define LDS_WAIT() asm volatile("s_waitcnt lgkmcnt(0)" ::: "memory")
#define VM_WAIT() asm volatile("s_waitcnt vmcnt(0)" ::: "memory")
__device__ __forceinline__ unsigned f2bf(float f) { unsigned u = __builtin_bit_cast(unsigned, f); return (u + 0x7fffu + ((u >> 16) & 1u)) >> 16; }
__device__ __forceinline__ unsigned pk2(float lo, float hi) { return f2bf(lo) | (f2bf(hi) << 16); }
__device__ __forceinline__ float bf2f(unsigned h) { return __builtin_bit_cast(float, h << 16); }
__device__ __forceinline__ float bflo(unsigned w) { return __builtin_bit_cast(float, w << 16); }
__device__ __forceinline__ float bfhi(unsigned w) { return __builtin_bit_cast(float, w & 0xffff0000u); }

#define XB_TMO      128
#define XB_XCNT(j)  (256  + 64 * (j))
#define XB_XSUB(j)  (1280 + 64 * (j))
#define XB_XGEN(j)  (2304 + 64 * (j))
#define XB_TOP      3328
#define XB_TOPGEN   3392
#define XCD_BAR_WORDS 3456
#define XB_SPIN_CAP (1u << 18)

__device__ __forceinline__ unsigned xb_ld(unsigned* p)              { return __hip_atomic_load(p, __ATOMIC_RELAXED, __HIP_MEMORY_SCOPE_AGENT); }
__device__ __forceinline__ unsigned xb_add(unsigned* p, unsigned v) { return __hip_atomic_fetch_add(p, v, __ATOMIC_RELAXED, __HIP_MEMORY_SCOPE_AGENT); }
__device__ __forceinline__ unsigned xb_xcc_id() { return (unsigned)__builtin_amdgcn_s_getreg((3 << 11) | 20) & 0xFu; }
#define XB_SPIN(cond, bar) do { unsigned _sp = 0; while (cond) { __builtin_amdgcn_s_sleep(1); \
    if ((++_sp & 255u) == 0u) { if (xb_ld(&(bar)[XB_TMO])) break; if (_sp > XB_SPIN_CAP) { atomicAdd(&(bar)[XB_TMO], 1u); break; } } } } while (0)

struct XcdBarrier {
    unsigned* bar; unsigned x;
    volatile LAS unsigned* st;
};

__device__ __forceinline__ XcdBarrier xcd_barrier_post(unsigned* bar, volatile LAS unsigned* st, bool t0) {
    XcdBarrier b; b.bar = bar; b.x = xb_xcc_id(); b.st = st;
    if (t0) (void)xb_add(&bar[XB_XCNT(b.x)], 1u);
    return b;
}
__device__ __forceinline__ void xcd_barrier_complete(unsigned* bar, unsigned x, unsigned& nloc, unsigned& nx) {
    const unsigned G = gridDim.x * gridDim.y * gridDim.z;
    unsigned sum, cnt, mine, sp = 0u;
    for (;;) {
        sum = 0u; cnt = 0u; mine = 0u;
#pragma unroll
        for (unsigned j = 0; j < 16; ++j) { const unsigned c = xb_ld(&bar[XB_XCNT(j)]); sum += c; cnt += (c > 0u) ? 1u : 0u; mine = (j == x) ? c : mine; }
        if (sum == G) break;
        __builtin_amdgcn_s_sleep(1);
        if ((++sp & 255u) == 0u) { if (xb_ld(&bar[XB_TMO])) break; if (sp > XB_SPIN_CAP) { atomicAdd(&bar[XB_TMO], 1u); break; } }
    }
    nloc = mine > 0u ? mine : 1u; nx = cnt > 0u ? cnt : 1u;
}

__device__ __forceinline__ void xcd_barrier(const XcdBarrier& b, bool t0) {
    asm volatile("s_waitcnt vmcnt(0)" ::: "memory");
    __syncthreads();
    if (t0) {
        GAS unsigned* barg_ = (GAS unsigned*)b.bar; unsigned bx_ = b.x; asm volatile("" : "+s"(barg_), "+s"(bx_)); unsigned* bar = (unsigned*)barg_;
        __builtin_amdgcn_s_waitcnt(0);
        unsigned nloc = b.st[0], nx = b.st[1];
        if (nloc == 0u) { xcd_barrier_complete(bar, bx_, nloc, nx); b.st[0] = nloc; b.st[1] = nx; }
        const unsigned old = xb_add(&bar[XB_XSUB(bx_)], 1u);
        const unsigned gen = old / nloc;
        if (old + 1u == (gen + 1u) * nloc) {
            __builtin_amdgcn_fence(__ATOMIC_RELEASE, "agent");
            asm volatile("s_waitcnt vmcnt(0)" ::: "memory");
            const unsigned og = xb_add(&bar[XB_TOP], 1u);
            const unsigned tg = og / nx;
            if (og + 1u == (tg + 1u) * nx) xb_add(&bar[XB_TOPGEN], 1u);
            else XB_SPIN(xb_ld(&bar[XB_TOPGEN]) == tg, bar);
            __builtin_amdgcn_fence(__ATOMIC_ACQUIRE, "agent");
            xb_add(&bar[XB_XGEN(bx_)], 1u);
            asm volatile("s_waitcnt vmcnt(0)" ::: "memory");
        } else {
            XB_SPIN(xb_ld(&bar[XB_XGEN(bx_)]) == gen, bar);
            __builtin_amdgcn_fence(__ATOMIC_ACQUIRE, "agent");
            asm volatile("s_waitcnt vmcnt(0)" ::: "memory");
        }
    }
    __syncthreads();
}

struct Frame {
    LAS unsigned char* lds;
    volatile LAS unsigned* MISC;
    gu32* ctl;
    int tid, lane, wave, vcu, G, bx;
    float* out; unsigned char* ws;
};
#define WSP(T_, off) ((T_*)(F.ws + (off)))
__device__ __forceinline__ const float* fin(const Frame& F, int k) {
    const volatile LAS unsigned* p = (const volatile LAS unsigned*)(F.lds + LDSCTL_OFF) + 2 * k;
    const unsigned lo = __builtin_amdgcn_readfirstlane(p[0]), hi = __builtin_amdgcn_readfirstlane(p[1]);
    return (const float*)(const GAS float*)(((unsigned long long)hi << 32) | lo);
}

#define WS_STEP(v, pat) v += __builtin_bit_cast(float, __builtin_amdgcn_ds_swizzle(__builtin_bit_cast(int, v), pat))
__device__ __forceinline__ float wave_sum(float v) {
    WS_STEP(v, 0x041F); WS_STEP(v, 0x081F); WS_STEP(v, 0x101F); WS_STEP(v, 0x201F); WS_STEP(v, 0x401F);
    const int iv = __builtin_bit_cast(int, v);
    return __builtin_bit_cast(float, __builtin_amdgcn_readlane(iv, 0)) + __builtin_bit_cast(float, __builtin_amdgcn_readlane(iv, 32));
}
__device__ __forceinline__ int lane_get(int v, int src_lane) { return __builtin_amdgcn_ds_bpermute(src_lane * 4, v); }

__device__ __forceinline__ void transpose_item(const float* W, int ldw, int K, bf16* WT, int k0, int n0, int drow0, LAS float* scr, int lane, const float* rs) {
#pragma unroll 8
    for (int i = 0; i < 32; ++i) { const int kk = 2 * i + (lane >> 5); scr[kk * 33 + (lane & 31)] = W[(size_t)(k0 + kk) * ldw + n0 + (lane & 31)]; }
    LDS_WAIT(); asm volatile("" ::: "memory");
    const int c = lane & 7;
#pragma unroll
    for (int j = 0; j < 4; ++j) { const int n = (lane >> 3) + 8 * j; const LAS float* s = scr + (8 * c) * 33 + n; const float f = rs ? rs[n0 + n] : 1.f;
        v4u o; o.x = pk2(s[0 * 33] * f, s[1 * 33] * f); o.y = pk2(s[2 * 33] * f, s[3 * 33] * f); o.z = pk2(s[4 * 33] * f, s[5 * 33] * f); o.w = pk2(s[6 * 33] * f, s[7 * 33] * f);
        *(v4u*)(WT + (size_t)(drow0 + n) * K + k0 + 8 * c) = o; }
    LDS_WAIT(); asm volatile("" ::: "memory");
}
template <int MODE> __device__ __forceinline__ int drow_of(int n0) {
    if (MODE == 1) { if (n0 >= 3072) return n0; const int blk = (n0 >> 6) & 3, sw = (blk == 1) ? 2 : (blk == 2 ? 1 : blk); return (n0 & ~255) + sw * 64 + (n0 & 63); }
    if (MODE == 2) return ((n0 >> 7) << 8) + (n0 & 127);
    if (MODE == 3) return ((n0 >> 7) << 8) + 128 + (n0 & 127);
    return n0;
}
template <int MODE> __device__ __forceinline__ void transpose_class(Frame& F, const float* src, size_t sstride, int nmat, int K, int ncols, int ldw, bf16* dst, size_t dstride, LAS float* scr, const float* rscale = nullptr, int rsstride = 0) {
    const int gw = F.vcu * NWAVES + F.wave, NGW = F.G * NWAVES;
    const int nkb = K / 64, nnb = ncols / 32, ipm = nkb * nnb, total = nmat * ipm;
    for (int it = gw; it < total; it += NGW) {
        const int mat = it / ipm, r = it - mat * ipm, kb = r / nnb, nb = r - kb * nnb;
        transpose_item(src + (size_t)mat * sstride, ldw, K, dst + (size_t)mat * dstride, kb * 64, nb * 32, drow_of<MODE>(nb * 32), scr, F.lane, rscale ? rscale + (size_t)mat * rsstride : nullptr);
    }
}
__device__ __forceinline__ void rms_row(const f32x4 (&v)[8], const f32x4 (&g)[8], f32x4 (&hv)[8]) {
    float s = 0.f;
#pragma unroll
    for (int j = 0; j < 8; ++j) s += (v[j].x * v[j].x + v[j].y * v[j].y) + (v[j].z * v[j].z + v[j].w * v[j].w);
    const float rstd = 1.f / sqrtf(wave_sum(s) * (1.f / DM) + RMS_EPS);
#pragma unroll
    for (int j = 0; j < 8; ++j) hv[j] = v[j] * rstd * g[j];
}
__device__ __forceinline__ void store_row_bf16(bf16* orow, const f32x4 (&hv)[8], int lane) {
    v2u* o8 = (v2u*)orow + lane;
#pragma unroll
    for (int j = 0; j < 8; ++j) { v2u w; w.x = pk2(hv[j].x, hv[j].y); w.y = pk2(hv[j].z, hv[j].w); o8[64 * j] = w; }
}
__device__ __forceinline__ void load_row_f32(const float* xrow, f32x4 (&v)[8], int lane) {
    const f32x4* xr = (const f32x4*)xrow + lane;
#pragma unroll
    for (int j = 0; j < 8; ++j) v[j] = xr[64 * j];
}
__device__ __forceinline__ void add_row_bf16(const bf16* yrow, f32x4 (&v)[8], int lane) {
    const v2u* yr = (const v2u*)yrow + lane;
#pragma unroll
    for (int j = 0; j < 8; ++j) { const v2u w = yr[64 * j]; v[j].x += bflo(w.x); v[j].y += bfhi(w.x); v[j].z += bflo(w.y); v[j].w += bfhi(w.y); }
}

__device__ __forceinline__ void p0_prologue(Frame& F) {
    LAS float* scr = (LAS float*)(F.lds + RING_OFF + F.wave * 16384);
    const int gw = F.vcu * NWAVES + F.wave, NGW = F.G * NWAVES;
    transpose_class<0>(F, fin(F, 6), (size_t)DM * DM, 4, DM, DM, DM, WSP(bf16, WS_WOUT), (size_t)DM * DM, scr);
    transpose_class<0>(F, fin(F, 7), (size_t)DM * 1024, 4, DM, 1024, 1024, WSP(bf16, WS_WMKV), (size_t)1024 * DM, scr);
    transpose_class<0>(F, fin(F, 8), 0, 1, DM, 2048, 2048, WSP(bf16, WS_WIN0), 0, scr);
    transpose_class<0>(F, fin(F, 8) + (size_t)DM * 2048, 0, 1, DM, 2048, 2048, WSP(bf16, WS_WIN3), 0, scr);
    transpose_class<1>(F, fin(F, 11), 0, 1, DM, 5120, 5120, WSP(bf16, WS_WIN1), 0, scr);
    transpose_class<0>(F, fin(F, 14), 0, 1, DM, 4096, 4632, WSP(bf16, WS_WIN2), 0, scr);
    transpose_class<0>(F, fin(F, 14) + 4120, 0, 1, DM, 512, 4632, WSP(bf16, WS_WIN2) + (size_t)4096 * DM, 0, scr);
    transpose_class<0>(F, fin(F, 9), (size_t)384 * 384, 8, 384, 384, 384, WSP(bf16, WS_WGRP), (size_t)512 * 384, scr, fin(F, 10), 384);
    transpose_class<2>(F, fin(F, 25), (size_t)DM * DE, 64, DM, DE, DE, WSP(bf16, WS_WGU), (size_t)1024 * DM, scr);
    transpose_class<3>(F, fin(F, 26), (size_t)DM * DE, 64, DM, DE, DE, WSP(bf16, WS_WGU), (size_t)1024 * DM, scr);
    transpose_class<0>(F, fin(F, 27), (size_t)DE * DM, 64, DE, DM, DM, WSP(bf16, WS_WD), (size_t)DM * DE, scr);
    { float* wrt = WSP(float, WS_WRT); const int gt = (F.vcu * NWAVES + F.wave) * 64 + F.lane, NGT = NGW * 64;
      for (int i = gt; i < 4 * 20 * DM; i += NGT) { const int L = i / (20 * DM), r = i - L * 20 * DM, e = r / DM, k = r - e * DM;
          wrt[i] = (e < 4) ? fin(F, 21)[((size_t)L * DM + k) * 4 + e] : fin(F, 23)[((size_t)L * DM + k) * 16 + (e - 4)]; }
      float* wdt = WSP(float, WS_WDT);
      for (int i = gt; i < DTW * DM; i += NGT) { const int j = i / DM, k = i - j * DM; wdt[i] = fin(F, 14)[(size_t)k * 4632 + 4096 + j]; } }
    if (gw == NGW - 1) {
        double inv = 1.0; for (int i = 0; i < F.lane; ++i) inv *= 0.8659643233600653;
        double cd = 1.0, sd = 0.0;
        { double t = 1.0, x2 = inv * inv; cd = 0.0; for (int k = 0; k < 12; ++k) { cd += t; t *= -x2 / (double)((2 * k + 1) * (2 * k + 2)); }
          t = inv; sd = 0.0; for (int k = 0; k < 12; ++k) { sd += t; t *= -x2 / (double)((2 * k + 2) * (2 * k + 3)); } }
        double c = 1.0, s = 0.0; float* ct = WSP(float, WS_COS); float* st = WSP(float, WS_SIN);
        for (int p = 0; p < SEQ; ++p) { ct[p * 64 + F.lane] = (float)c; st[p * 64 + F.lane] = (float)s; const double c2 = c * cd - s * sd, s2 = s * cd + c * sd; c = c2; s = s2; }
    }
    for (int r = gw; r < NLAYER * BATCH * MEML; r += NGW) { const int L = r / (BATCH * MEML), m = r - L * (BATCH * MEML);
        f32x4 v[8], g[8], hv[8]; load_row_f32(fin(F, 1) + (size_t)m * DM, v, F.lane); load_row_f32(fin(F, 3) + (size_t)L * DM, g, F.lane);
        rms_row(v, g, hv); store_row_bf16(WSP(bf16, WS_MEMN) + (size_t)r * DM, hv, F.lane); }
}

__device__ __forceinline__ void phase_n1(Frame& F, int L) {
    const int gw = F.vcu * NWAVES + F.wave, NGW = F.G * NWAVES;
    f32x4 g[8]; load_row_f32(fin(F, 2) + (size_t)L * DM, g, F.lane);
    float* X = WSP(float, WS_X); bf16* H = WSP(bf16, WS_H); const bf16* Y = WSP(bf16, WS_BIG); const int* slot = WSP(int, WS_SLOT);
    for (int m = gw; m < T; m += NGW) {
        f32x4 v[8], hv[8];
        if (L == 0) load_row_f32(fin(F, 0) + (size_t)m * DM, v, F.lane);
        else { load_row_f32(X + (size_t)m * DM, v, F.lane); const int s0 = slot[2 * m], s1 = slot[2 * m + 1];
               if (!ABL_NOMOE) { add_row_bf16(Y + (size_t)s0 * DM, v, F.lane); add_row_bf16(Y + (size_t)s1 * DM, v, F.lane); } }
        { f32x4* xo = (f32x4*)(X + (size_t)m * DM) + F.lane;
#pragma unroll
          for (int j = 0; j < 8; ++j) xo[64 * j] = v[j]; }
        rms_row(v, g, hv); store_row_bf16(H + (size_t)m * DM, hv, F.lane);
        if (L == 2) { const float* wdt = WSP(float, WS_WDT); float* dt = WSP(float, WS_DT);
#pragma unroll 1
            for (int j = 0; j < DTW; ++j) { const f32x4* wr = (const f32x4*)(wdt + (size_t)j * DM) + F.lane; float s = 0.f;
#pragma unroll
                for (int i = 0; i < 8; ++i) { const f32x4 w = wr[64 * i]; s += (hv[i].x * w.x + hv[i].y * w.y) + (hv[i].z * w.z + hv[i].w * w.w); }
                s = wave_sum(s); if (F.lane == 0) dt[(size_t)m * DTW + j] = s; } }
    }
}
__device__ __forceinline__ void phase_final(Frame& F) {
    const int gw = F.vcu * NWAVES + F.wave, NGW = F.G * NWAVES;
    f32x4 g[8]; load_row_f32(fin(F, 5), g, F.lane);
    const float* X = WSP(float, WS_X); const bf16* Y = WSP(bf16, WS_BIG); const int* slot = WSP(int, WS_SLOT);
    for (int m = gw; m < T; m += NGW) {
        f32x4 v[8], hv[8]; load_row_f32(X + (size_t)m * DM, v, F.lane); const int s0 = slot[2 * m], s1 = slot[2 * m + 1];
        if (!ABL_NOMOE) { add_row_bf16(Y + (size_t)s0 * DM, v, F.lane); add_row_bf16(Y + (size_t)s1 * DM, v, F.lane); }
        rms_row(v, g, hv);
        f32x4* xo = (f32x4*)(F.out + (size_t)m * DM) + F.lane;
#pragma unroll
        for (int j = 0; j < 8; ++j) xo[64 * j] = hv[j];
    }
#if DBG_CHECKS
    if (gw == 0 && F.lane == 0) { const unsigned c = __hip_atomic_load((unsigned*)(F.ctl + CW_DBG), RLX_AGENT); if (c) { asm volatile("s_waitcnt vmcnt(0)" ::: "memory"); F.out[0] = 100.f * (float)c; } }
#endif
}

__device__ __forceinline__ void phase_n2(Frame& F, int L) {
    LAS int* lcnt = (LAS int*)(F.lds + RING_OFF); LAS int* lbase = lcnt + 16; LAS int* rinfo = lcnt + 32; LAS float* rwt = (LAS float*)(lcnt + 32 + 128);
    f32x4 g[8]; load_row_f32(fin(F, 4) + (size_t)L * DM, g, F.lane);
    const float* X = WSP(float, WS_X); bf16* H = WSP(bf16, WS_H); const float* wrt = WSP(float, WS_WRT) + (size_t)L * 20 * DM;
    const float* bg = fin(F, 22) + L * 4; const float* be = fin(F, 24) + L * 16;
    for (int rb = F.bx; rb < T / 32; rb += F.G) {
        if (F.tid < 16) lcnt[F.tid] = 0;
        __syncthreads();
        for (int i = 0; i < 4; ++i) {
            const int rl = F.wave * 4 + i, m = rb * 32 + rl;
            f32x4 v[8], hv[8]; load_row_f32(X + (size_t)m * DM, v, F.lane);
            rms_row(v, g, hv); store_row_bf16(H + (size_t)m * DM, hv, F.lane);
            LAS float* lgl = (LAS float*)(lcnt + 32 + 128 + 64) + F.wave * 20;
#pragma unroll 1
            for (int e = 0; e < 20; ++e) { const f32x4* wr = (const f32x4*)(wrt + (size_t)e * DM) + F.lane; float s = 0.f;
#pragma unroll
                for (int j = 0; j < 8; ++j) { const f32x4 w = wr[64 * j]; s += (hv[j].x * w.x + hv[j].y * w.y) + (hv[j].z * w.z + hv[j].w * w.w); }
                s = wave_sum(s); if (F.lane == 0) lgl[e] = s; }
            LDS_WAIT(); asm volatile("" ::: "memory");
            float lg[20];
#pragma unroll
            for (int e = 0; e < 20; ++e) lg[e] = lgl[e];
            float gl[4];
#pragma unroll
            for (int q = 0; q < 4; ++q) gl[q] = lg[q] + bg[q];
            int gsel = 0; float gmax = gl[0];
#pragma unroll
            for (int q = 1; q < 4; ++q) if (gl[q] > gmax) { gmax = gl[q]; gsel = q; }
            float gsum = 0.f;
#pragma unroll
            for (int q = 0; q < 4; ++q) gsum += __expf(gl[q] - gmax);
            const float gwt = 1.f / gsum;
            float el[4];
#pragma unroll
            for (int q = 0; q < 4; ++q) { const float a0 = lg[4 + q] + be[q], a1 = lg[8 + q] + be[4 + q], a2 = lg[12 + q] + be[8 + q], a3 = lg[16 + q] + be[12 + q];
                el[q] = gsel == 0 ? a0 : (gsel == 1 ? a1 : (gsel == 2 ? a2 : a3)); }
            int i1 = 0; float m1 = el[0];
#pragma unroll
            for (int q = 1; q < 4; ++q) if (el[q] > m1) { m1 = el[q]; i1 = q; }
            int i2 = -1; float m2 = -3.0e38f;
#pragma unroll
            for (int q = 0; q < 4; ++q) if (q != i1 && el[q] > m2) { m2 = el[q]; i2 = q; }
            const float r21 = __expf(m2 - m1);
            const float w1 = gwt / (1.f + r21), w2 = gwt * r21 / (1.f + r21);
            if (F.lane == 0) { const int e0 = gsel * 4 + i1, e1 = gsel * 4 + i2;
                const int r0 = __hip_atomic_fetch_add(lcnt + e0, 1, __ATOMIC_RELAXED, __HIP_MEMORY_SCOPE_WORKGROUP);
                const int r1 = __hip_atomic_fetch_add(lcnt + e1, 1, __ATOMIC_RELAXED, __HIP_MEMORY_SCOPE_WORKGROUP);
                rinfo[rl * 4 + 0] = e0; rinfo[rl * 4 + 1] = e1; rinfo[rl * 4 + 2] = r0; rinfo[rl * 4 + 3] = r1; rwt[rl * 2] = w1; rwt[rl * 2 + 1] = w2; }
        }
        __syncthreads();
        if (F.tid < 16) lbase[F.tid] = (int)__hip_atomic_fetch_add((unsigned*)(F.ctl + CW_CNT + 64 * L + F.tid), (unsigned)lcnt[F.tid], RLX_AGENT);
        __syncthreads();
        if (F.tid < 32) { const int m = rb * 32 + F.tid; const int e0 = rinfo[F.tid * 4], e1 = rinfo[F.tid * 4 + 1];
            v4i a; a.x = e0; a.y = lbase[e0] + rinfo[F.tid * 4 + 2]; a.z = e1; a.w = lbase[e1] + rinfo[F.tid * 4 + 3];
            WSP(v4i, WS_ASG)[m] = a; f32x2 w; w.x = rwt[F.tid * 2]; w.y = rwt[F.tid * 2 + 1]; WSP(f32x2, WS_ASGW)[m] = w; }
        __syncthreads();
    }
}
__device__ __forceinline__ int moe_off_lane(Frame& F, int L, int& padded_total) {
    int c = 0; if (F.lane < 16) c = (int)__hip_atomic_load((unsigned*)(F.ctl + CW_CNT + 64 * L + F.lane), RLX_AGENT);
    const int pc = (c + 255) & ~255; int incl = pc;
#pragma unroll
    for (int o = 1; o < 16; o <<= 1) { const int t = lane_get(incl, F.lane - o); if (F.lane >= o) incl += t; }
    padded_total = lane_get(incl, 15);
    return incl - pc;
}
__device__ __forceinline__ void phase_s1(Frame& F, int L) {
    const int gw = F.vcu * NWAVES + F.wave, NGW = F.G * NWAVES;
    int ptot; const int offl = moe_off_lane(F, L, ptot);
    const bf16* H = WSP(bf16, WS_H); bf16* TS = WSP(bf16, WS_BIG); float* gws = WSP(float, WS_GWS); int* slot = WSP(int, WS_SLOT);
    for (int m = gw; m < T; m += NGW) {
        const v4i a = WSP(v4i, WS_ASG)[m]; const f32x2 w = WSP(f32x2, WS_ASGW)[m];
        const int s0 = lane_get(offl, a.x) + a.y, s1 = lane_get(offl, a.z) + a.w;
        const v4u* src = (const v4u*)(H + (size_t)m * DM) + F.lane; v4u* d0 = (v4u*)(TS + (size_t)s0 * DM) + F.lane; v4u* d1 = (v4u*)(TS + (size_t)s1 * DM) + F.lane;
#pragma unroll
        for (int j = 0; j < 4; ++j) { const v4u x = src[64 * j]; d0[64 * j] = x; d1[64 * j] = x; }
        if (F.lane == 0) { slot[2 * m] = s0; slot[2 * m + 1] = s1; gws[s0] = w.x; gws[s1] = w.y; }
    }
}

struct G1Order {
    pg8::StaticOrder so; int nin, nextra, G, c, rope_tiles;
    __device__ __forceinline__ bool next(int i, pg8::Unit& u) const {
        const int L = i * G + c;
        if (L < nin) { pg8::StaticOrder t = so; t.G = 1; t.c = L; t.next(0, u); u.om = u.pm * 256; u.on = u.pn * 256; u.aux = (u.pn < rope_tiles) ? 1 : 0; return true; }
        const int r = L - nin; if (r >= nextra) return false;
        const int li = r >> 4, pml = (r >> 2) & 3, pnl = r & 3;
        u.pm = 32 + li * 4 + pml; u.pn = 8 + li * 4 + pnl; u.om = li * 1024 + pml * 256; u.on = pnl * 256; u.aux = 4; return true;
    }
    __device__ __forceinline__ void a_ready(const pg8::Unit&) const {}
    __device__ __forceinline__ void done(const pg8::Unit&) const {}
};
struct PlainOrder {
    pg8::StaticOrder so;
    __device__ __forceinline__ bool next(int i, pg8::Unit& u) const { if (!so.next(i, u)) return false; u.om = u.pm * 256; u.on = u.pn * 256; return true; }
    __device__ __forceinline__ void a_ready(const pg8::Unit&) const {}
    __device__ __forceinline__ void done(const pg8::Unit&) const {}
};
struct PoolOrder {
    int G, c;
    __device__ __forceinline__ bool next(int i, pg8::Unit& u) const {
        const int L = i * G + c; if (L >= 256) return false;
        const int g = L >> 6, r = L & 63, pml = r >> 1, pnl = r & 1;
        u.pm = g * 32 + pml; u.pn = g * 2 + pnl; u.om = pml * 256; u.on = g * 384 + pnl * 256; u.aux = pnl ? 2 : 0; return true;
    }
    __device__ __forceinline__ void a_ready(const pg8::Unit&) const {}
    __device__ __forceinline__ void done(const pg8::Unit&) const {}
};
struct MoeOrder {
    volatile LAS int* pref; int ntn, onstep, total, G, c;
    __device__ __forceinline__ bool next(int i, pg8::Unit& u) const {
        const int L = i * G + c; if (L >= total) return false;
        const int mt = L / ntn, pnl = L - mt * ntn; int e = 0;
#pragma unroll
        for (int k = 1; k < 16; ++k) e += (mt >= pref[k]) ? 1 : 0;
        u.pm = mt; u.pn = e * ntn + pnl; u.om = mt * 256; u.on = pnl * onstep; u.aux = 0; return true;
    }
    __device__ __forceinline__ void a_ready(const pg8::Unit&) const {}
    __device__ __forceinline__ void done(const pg8::Unit&) const {}
};
__device__ __forceinline__ int moe_build_pref(Frame& F, int L) {
    __syncthreads();
    if (F.tid == 0) { int acc = 0;
        for (int e = 0; e < 16; ++e) { F.MISC[16 + e] = (unsigned)acc; const int c = (int)__hip_atomic_load((unsigned*)(F.ctl + CW_CNT + 64 * L + e), RLX_AGENT); acc += (c + 255) >> 8; }
        F.MISC[32] = (unsigned)acc; }
    __syncthreads();
    return (int)F.MISC[32];
}

template <int G_> __device__ __forceinline__ void pool_prep_group(const bf16* P, bf16* MX, int m, int s, int lane) {
    constexpr int W = 2 << G_;
    if (lane >= 48) return;
    const int cnt = (s + 1 < W) ? s + 1 : W, c = G_ * 384 + 8 * lane;
    const bf16* p = P + (size_t)m * 2048 + c;
    float acc[8] = {0.f, 0.f, 0.f, 0.f, 0.f, 0.f, 0.f, 0.f};
    const v4u cur = *(const v4u*)p;
#pragma unroll
    for (int k = 0; k < W; ++k) { if (k < cnt) { const v4u x = *(const v4u*)(p - (size_t)k * 2048);
            acc[0] += bflo(x.x); acc[1] += bfhi(x.x); acc[2] += bflo(x.y); acc[3] += bfhi(x.y); acc[4] += bflo(x.z); acc[5] += bfhi(x.z); acc[6] += bflo(x.w); acc[7] += bfhi(x.w); } }
    const float ic = 1.f / (float)cnt;
    v4u o; o.x = pk2(acc[0] * ic - bflo(cur.x), acc[1] * ic - bfhi(cur.x)); o.y = pk2(acc[2] * ic - bflo(cur.y), acc[3] * ic - bfhi(cur.y));
    o.z = pk2(acc[4] * ic - bflo(cur.z), acc[5] * ic - bfhi(cur.z)); o.w = pk2(acc[6] * ic - bflo(cur.w), acc[7] * ic - bfhi(cur.w));
    *(v4u*)(MX + ((size_t)G_ * T + m) * 384 + 8 * lane) = o;
}
__device__ __forceinline__ void phase_pool_prep(Frame& F) {
    const int gw = F.vcu * NWAVES + F.wave, NGW = F.G * NWAVES;
    const bf16* P = WSP(bf16, WS_BIG); bf16* MX = WSP(bf16, WS_MIX);
    for (int m = gw; m < T; m += NGW) {
        const int s = m & (SEQ - 1);
        pool_prep_group<0>(P, MX, m, s, F.lane); pool_prep_group<1>(P, MX, m, s, F.lane); pool_prep_group<2>(P, MX, m, s, F.lane); pool_prep_group<3>(P, MX, m, s, F.lane);
    }
}
__device__ __forceinline__ void phase_diff_combine(Frame& F, int L) {
    const int gw = F.vcu * NWAVES + F.wave, NGW = F.G * NWAVES;
    const float* lam = fin(F, 12);
    float s1 = lam[F.lane] * lam[128 + F.lane] + lam[64 + F.lane] * lam[192 + F.lane], s2 = lam[256 + F.lane] * lam[384 + F.lane] + lam[320 + F.lane] * lam[448 + F.lane];
    s1 = wave_sum(s1); s2 = wave_sum(s2);
    const float linit = 0.8f - 0.6f * expf(-0.3f * (float)L);
    const float lmb = expf(s1) - expf(s2) + linit, post = 1.f - linit;
    const f32x4 sg = *((const f32x4*)fin(F, 13) + F.lane);
    const bf16* OA = WSP(bf16, WS_OATT); bf16* CC = WSP(bf16, WS_CONCAT);
    for (int m = gw; m < T; m += NGW) {
#pragma unroll
        for (int h = 0; h < 6; ++h) {
            const v2u a = *((const v2u*)(OA + (size_t)m * 3072 + h * 512) + F.lane), b = *((const v2u*)(OA + (size_t)m * 3072 + h * 512 + 256) + F.lane);
            f32x4 d; d.x = bflo(a.x) - lmb * bflo(b.x); d.y = bfhi(a.x) - lmb * bfhi(b.x); d.z = bflo(a.y) - lmb * bflo(b.y); d.w = bfhi(a.y) - lmb * bfhi(b.y);
            const float ss = wave_sum((d.x * d.x + d.y * d.y) + (d.z * d.z + d.w * d.w));
            const float r = post / sqrtf(ss * (1.f / 256.f) + RMS_EPS);
            v2u o; o.x = pk2(d.x * r * sg.x, d.y * r * sg.y); o.y = pk2(d.z * r * sg.z, d.w * r * sg.w);
            *((v2u*)(CC + (size_t)m * 2048 + h * 256) + F.lane) = o;
        }
    }
}
__device__ __forceinline__ void phase_ssd_norm(Frame& F) {
    const int gw = F.vcu * NWAVES + F.wave, NGW = F.G * NWAVES;
    const bf16* YB = WSP(bf16, WS_MIX); bf16* CC = WSP(bf16, WS_CONCAT); const float* ng = fin(F, 20);
    for (int m = gw; m < T; m += NGW) {
        float v[3][8]; float ps[4] = {0.f, 0.f, 0.f, 0.f};
#pragma unroll
        for (int j = 0; j < 3; ++j) { const int c = 512 * j + 8 * F.lane, g = c / 384; const v4u x = *(const v4u*)(YB + (size_t)m * 1536 + c);
            v[j][0] = bflo(x.x); v[j][1] = bfhi(x.x); v[j][2] = bflo(x.y); v[j][3] = bfhi(x.y); v[j][4] = bflo(x.z); v[j][5] = bfhi(x.z); v[j][6] = bflo(x.w); v[j][7] = bfhi(x.w);
            float s = 0.f;
#pragma unroll
            for (int i = 0; i < 8; ++i) s += v[j][i] * v[j][i];
#pragma unroll
            for (int q = 0; q < 4; ++q) ps[q] += (g == q) ? s : 0.f; }
        float rs[4];
#pragma unroll
        for (int q = 0; q < 4; ++q) rs[q] = 1.f / sqrtf(wave_sum(ps[q]) * (1.f / 384.f) + RMS_EPS);
#pragma unroll
        for (int j = 0; j < 3; ++j) { const int c = 512 * j + 8 * F.lane, g = c / 384; const float r = g == 0 ? rs[0] : (g == 1 ? rs[1] : (g == 2 ? rs[2] : rs[3]));
            const f32x4 g0 = *(const f32x4*)(ng + c), g1 = *(const f32x4*)(ng + c + 4);
            v4u o; o.x = pk2(v[j][0] * r * g0.x, v[j][1] * r * g0.y); o.y = pk2(v[j][2] * r * g0.z, v[j][3] * r * g0.w);
            o.z = pk2(v[j][4] * r * g1.x, v[j][5] * r * g1.y); o.w = pk2(v[j][6] * r * g1.z, v[j][7] * r * g1.w);
            *(v4u*)(CC + (size_t)m * 2048 + c) = o; }
    }
}
__device__ __forceinline__ float silu_f(float v) { return v / (1.f + __expf(-v)); }
__device__ __forceinline__ void ssd_scan_item(Frame& F, int item) {
    constexpr int CH = 32, LDP = 4608;
    const int b = item / 24, hh = item - b * 24, g = hh / 6, tid = F.tid, w = F.wave, lane = F.lane;
    LAS float* xs = (LAS float*)(F.lds + RING_OFF); LAS float* Bs = xs + CH * 64; LAS float* Cs = Bs + CH * 128; LAS float* dts = Cs + CH * 128; LAS float* dAs = dts + CH; LAS float* yp = dAs + CH;
    const bf16* P = WSP(bf16, WS_BIG); const float* DT = WSP(float, WS_DT); bf16* YB = WSP(bf16, WS_MIX);
    const float Aneg = -expf(fin(F, 18)[hh]), Dk = fin(F, 19)[hh], dtb = fin(F, 17)[hh];
    int ch = 0; LAS float* sdst = xs; int sld = 64;
    if (tid < 64) { ch = hh * 64 + tid; sdst = xs + tid; sld = 64; }
    else if (tid < 192) { ch = 1536 + g * 128 + (tid - 64); sdst = Bs + (tid - 64); sld = 128; }
    else if (tid < 320) { ch = 2048 + g * 128 + (tid - 192); sdst = Cs + (tid - 192); sld = 128; }
    float cw0 = 0.f, cw1 = 0.f, cw2 = 0.f, cw3 = 0.f, cb = 0.f;
    if (tid < 320) { const float* cwp = fin(F, 15); cw0 = cwp[ch]; cw1 = cwp[2560 + ch]; cw2 = cwp[5120 + ch]; cw3 = cwp[7680 + ch]; cb = fin(F, 16)[ch]; }
    float um3 = 0.f, um2 = 0.f, um1 = 0.f;
    float h[16];
#pragma unroll
    for (int i = 0; i < 16; ++i) h[i] = 0.f;
    for (int c = 0; c < SEQ / CH; ++c) {
        const size_t row0 = (size_t)b * SEQ + (size_t)c * CH;
        if (tid < 320) {
            const bf16* src = P + row0 * LDP + 1536 + ch;
            unsigned short raw[CH];
#pragma unroll
            for (int s = 0; s < CH; ++s) raw[s] = src[(size_t)s * LDP];
#pragma unroll
            for (int s = 0; s < CH; ++s) { const float u0 = bf2f(raw[s]); const float val = cb + cw0 * um3 + cw1 * um2 + cw2 * um1 + cw3 * u0; um3 = um2; um2 = um1; um1 = u0; sdst[s * sld] = silu_f(val); }
        } else if (tid < 320 + CH) { const int s = tid - 320; const float x = ((ABL_SSD == 3) ? 0.f : DT[(row0 + s) * DTW + hh]) + dtb; const float dt = x > 20.f ? x : log1pf(__expf(x)); dts[s] = dt; dAs[s] = __expf(dt * Aneg); }
        __syncthreads();
        for (int s = 0; s < CH; ++s) {
            const float dA = dAs[s], dtx = dts[s] * xs[s * 64 + lane];
            const LAS f32x4* bp = (const LAS f32x4*)(Bs + s * 128 + 16 * w); const LAS f32x4* cp = (const LAS f32x4*)(Cs + s * 128 + 16 * w);
            float acc = 0.f;
#pragma unroll
            for (int q = 0; q < 4; ++q) { const f32x4 bv = bp[q], cv = cp[q];
                h[4 * q + 0] = dA * h[4 * q + 0] + dtx * bv.x; acc += h[4 * q + 0] * cv.x; h[4 * q + 1] = dA * h[4 * q + 1] + dtx * bv.y; acc += h[4 * q + 1] * cv.y;
                h[4 * q + 2] = dA * h[4 * q + 2] + dtx * bv.z; acc += h[4 * q + 2] * cv.z; h[4 * q + 3] = dA * h[4 * q + 3] + dtx * bv.w; acc += h[4 * q + 3] * cv.w; }
            yp[(w * CH + s) * 64 + lane] = acc;
        }
        __syncthreads();
#pragma unroll
        for (int k = 0; k < 4; ++k) { const int idx = tid + 512 * k, s = idx >> 6, p = idx & 63; float y = (ABL_SSD == 2) ? 0.f : Dk * xs[s * 64 + p];
#pragma unroll
            for (int q = 0; q < 8; ++q) y += (ABL_SSD == 1) ? 0.f : yp[(q * CH + s) * 64 + p];
            const float z = bf2f(P[(row0 + s) * LDP + hh * 64 + p]);
            YB[(row0 + s) * 1536 + hh * 64 + p] = (bf16)f2bf(y * silu_f(z)); }
        __syncthreads();
    }
}

typedef att::BlockRef<att::bf16, att::bf16> ARef;
__device__ __forceinline__ ARef attn_decode(Frame& F, int L, int ncausal, int ldp, int idx) {
    ARef r; const att::bf16* P = (const att::bf16*)(F.ws + WS_BIG);
    if (idx < ncausal) {
        const int qb = 7 - idx / 96, q = idx % 96, vh = q & 1, c = (q >> 1) & 1, bh = q >> 2, b = bh / 6, h = bh - b * 6;
        r.Q = P + ((size_t)b * SEQ + qb * 256) * 5120 + h * 256 + c * 128; r.K = P + (size_t)b * SEQ * 5120 + 1536 + h * 256 + c * 128; r.V = P + (size_t)b * SEQ * 5120 + 3072 + h * 256 + vh * 128;
        r.O = (att::bf16*)(F.ws + WS_OATT) + ((size_t)b * SEQ + qb * 256) * 3072 + ((h * 2 + c) * 2 + vh) * 128;
        r.P0 = qb * 256; r.ldq = 5120; r.ldkv = 5120; r.ldo = 3072; r.skv = SEQ;
    } else {
        const int q = idx - ncausal, qb = q & 7, mh = (q >> 3) & 3, b = q >> 5;
        r.Q = P + ((size_t)b * SEQ + qb * 256) * ldp + (ldp - 512) + mh * 128;
        r.K = (const att::bf16*)(F.ws + WS_MEMKV) + ((size_t)L * 1024 + b * 256) * 1024 + mh * 128; r.V = r.K + 512;
        r.O = (att::bf16*)(F.ws + WS_CONCAT) + ((size_t)b * SEQ + qb * 256) * 2048 + 1536 + mh * 128;
        r.P0 = 1 << 20; r.ldq = ldp; r.ldkv = 1024; r.ldo = 2048; r.skv = MEML;
    }
    return r;
}
__device__ __forceinline__ int queue_fetch(Frame& F, int L) {
    if (F.tid == 0) F.MISC[12] = __hip_atomic_fetch_add((unsigned*)(F.ctl + CW_Q + 64 * L), 1u, RLX_AGENT);
    __syncthreads();
    const int v = (int)F.MISC[12];
    __syncthreads();
    return v;
}
__device__ __forceinline__ void phase_attn(Frame& F, int L, int ncausal, int ldp, char* lds) {
    const int total = ncausal + 128, W = 1 << 30;
    int idx = queue_fetch(F, L); if (idx >= total) return;
    ARef cur = attn_decode(F, L, ncausal, ldp, idx);
    att::Seam<att::bf16> S;
    att::causal_swa_prime<att::bf16, att::bf16>(cur, W, lds, S, F.tid);
    for (;;) {
        const int nidx = queue_fetch(F, L); const bool last = nidx >= total;
        const ARef nxt = last ? cur : attn_decode(F, L, ncausal, ldp, nidx);
        att::causal_swa_block<att::bf16, att::bf16>(cur, nxt, W, lds, S, F.tid);
        if (last) break;
        cur = nxt;
    }
}

__device__ __forceinline__ int lane_now() { int l; asm volatile("v_mbcnt_lo_u32_b32 %0, -1, 0\n\tv_mbcnt_hi_u32_b32 %0, -1, %0" : "=v"(l)); return l; }
__device__ __forceinline__ void abl_zero_mix(Frame& F) {
    const int gw = F.vcu * NWAVES + F.wave, NGW = F.G * NWAVES; bf16* CC = WSP(bf16, WS_CONCAT);
    for (int m = gw; m < T; m += NGW) { v4u z = {0u, 0u, 0u, 0u};
#pragma unroll
        for (int j = 0; j < 3; ++j) *(v4u*)(CC + (size_t)m * 2048 + 512 * j + 8 * F.lane) = z; }
}
#if DBG_CHECKS
__device__ __forceinline__ float bfr(float x) { return bf2f(f2bf(x)); }
__device__ __forceinline__ void dbg_flag(Frame& F, unsigned bit) { __hip_atomic_fetch_or((unsigned*)(F.ctl + CW_DBG), bit, RLX_AGENT); }
__device__ __forceinline__ bool dbg_bad(float got, float want, float rel, float ab) { const float d = fabsf(got - want); return !(d <= rel * fabsf(want) + ab); }
__device__ void dbg_check_l2_inputs(Frame& F) {
    const bf16* H = WSP(bf16, WS_H); const bf16* P = WSP(bf16, WS_BIG); const float* DT = WSP(float, WS_DT); const float* W = fin(F, 14);
    const float* X = WSP(float, WS_X); const float* gn = fin(F, 2) + 2 * DM; const bf16* WT = WSP(bf16, WS_WIN2); const float* wdt = WSP(float, WS_WDT);
    for (int a = 0; a < 3; ++a) { const int m = a == 0 ? 5 : (a == 1 ? 1000 : 5000);
        float ss = 0.f; for (int k = F.lane; k < DM; k += 64) { const float x = X[(size_t)m * DM + k]; ss += x * x; }
        ss = wave_sum(ss); const float rstd = 1.f / sqrtf(ss / DM + RMS_EPS); bool badh = false;
        for (int k = F.lane; k < DM; k += 64) badh |= dbg_bad(bf2f(H[(size_t)m * DM + k]), X[(size_t)m * DM + k] * rstd * gn[k], 0.01f, 0.01f);
        if (__any(badh) && F.lane == 0) dbg_flag(F, 1u);
        for (int j = 0; j < 24; j += 7) { float s = 0.f; for (int k = F.lane; k < DM; k += 64) s += bf2f(H[(size_t)m * DM + k]) * W[(size_t)k * 4632 + 4096 + j];
            s = wave_sum(s); if (F.lane == 0 && dbg_bad(DT[(size_t)m * DTW + j], s, 0.02f, 0.02f)) dbg_flag(F, 2u); }
        for (int q = 0; q < 4; ++q) { const int c = q == 0 ? 3 : (q == 1 ? 1600 : (q == 2 ? 3200 : 4100)), lc = c < 4096 ? c : c + 24; float s = 0.f;
            for (int k = F.lane; k < DM; k += 64) s += bf2f(H[(size_t)m * DM + k]) * bfr(W[(size_t)k * 4632 + lc]);
            s = wave_sum(s); if (F.lane == 0 && dbg_bad(bf2f(P[(size_t)m * 4608 + c]), s, 0.02f, 0.02f)) dbg_flag(F, (q == 0 && a == 0) ? 4u : 8u); } }
    bool badw = false, badt = false;
    for (int q = 0; q < 4; ++q) { const int c = q == 0 ? 3 : (q == 1 ? 1600 : (q == 2 ? 3200 : 4100)), lc = c < 4096 ? c : c + 24;
        for (int k = F.lane; k < DM; k += 64) badw |= (WT[(size_t)c * DM + k] != (bf16)f2bf(W[(size_t)k * 4632 + lc])); }
    for (int j = 0; j < 24; j += 7) for (int k = F.lane; k < DM; k += 64) badt |= (wdt[(size_t)j * DM + k] != W[(size_t)k * 4632 + 4096 + j]);
}
__device__ void dbg_check_hx(Frame& F, int L, unsigned bit) {
    const bf16* H = WSP(bf16, WS_H); const float* X = WSP(float, WS_X); const float* gn = fin(F, 2) + (size_t)L * DM;
    for (int a = 0; a < 3; ++a) { const int m = a == 0 ? 5 : (a == 1 ? 1000 : 5000);
        float ss = 0.f; for (int k = F.lane; k < DM; k += 64) { const float x = X[(size_t)m * DM + k]; ss += x * x; }
        ss = wave_sum(ss); const float rstd = 1.f / sqrtf(ss / DM + RMS_EPS); bool badh = false;
        for (int k = F.lane; k < DM; k += 64) badh |= dbg_bad(bf2f(H[(size_t)m * DM + k]), X[(size_t)m * DM + k] * rstd * gn[k], 0.01f, 0.01f);
        if (__any(badh) && F.lane == 0) dbg_flag(F, bit); }
}
__device__ void dbg_check_l2_scan(Frame& F) {
    const bf16* P = WSP(bf16, WS_BIG); const float* DT = WSP(float, WS_DT); const bf16* YB = WSP(bf16, WS_MIX);
    const float* cw = fin(F, 15); const float* cbp = fin(F, 16);
    for (int a = 0; a < 2; ++a) { const int hh = a ? 13 : 0, g = hh / 6; const float A = -expf(fin(F, 18)[hh]), Dk = fin(F, 19)[hh], dtb = fin(F, 17)[hh]; const size_t rb = (size_t)(a ? 2048 : 0);
        for (int pp = 0; pp < 2; ++pp) { const int p = pp ? 37 : 0;
            for (int ti = 0; ti < 6; ++ti) { const int t = ti == 0 ? 0 : (ti == 1 ? 3 : (ti == 2 ? 31 : (ti == 3 ? 32 : (ti == 4 ? 33 : 70))));
                float y = 0.f;
                for (int s = 0; s <= t; ++s) {
                    float cb_ = 0.f;
                    for (int n = F.lane; n < 128; n += 64) { float bv = cbp[1536 + g * 128 + n], cv = cbp[2048 + g * 128 + n];
                        for (int kk = 0; kk < 4; ++kk) { const int rs = s + kk - 3, rt = t + kk - 3;
                            if (rs >= 0) bv += cw[kk * 2560 + 1536 + g * 128 + n] * bf2f(P[(rb + rs) * 4608 + 1536 + 1536 + g * 128 + n]);
                            if (rt >= 0) cv += cw[kk * 2560 + 2048 + g * 128 + n] * bf2f(P[(rb + rt) * 4608 + 1536 + 2048 + g * 128 + n]); }
                        cb_ += silu_f(bv) * silu_f(cv); }
                    cb_ = wave_sum(cb_);
                    float xv = cbp[hh * 64 + p];
                    for (int kk = 0; kk < 4; ++kk) { const int rs = s + kk - 3; if (rs >= 0) xv += cw[kk * 2560 + hh * 64 + p] * bf2f(P[(rb + rs) * 4608 + 1536 + hh * 64 + p]); }
                    xv = silu_f(xv);
                    float dsum = 0.f; for (int r = s + 1; r <= t; ++r) { const float xr = DT[(rb + r) * DTW + hh] + dtb; dsum += (xr > 20.f ? xr : log1pf(__expf(xr))) * A; }
                    const float xs_ = DT[(rb + s) * DTW + hh] + dtb; const float dts_ = xs_ > 20.f ? xs_ : log1pf(__expf(xs_));
                    y += cb_ * __expf(dsum) * dts_ * xv; if (s == t) y += Dk * xv;
                }
                const float z = bf2f(P[(rb + t) * 4608 + hh * 64 + p]);
                if (F.lane == 0 && dbg_bad(bf2f(YB[(rb + t) * 1536 + hh * 64 + p]), y * silu_f(z), 0.03f, 0.01f)) dbg_flag(F, (t < 31) ? 4u : 8u);
                if (F.lane == 0 && t == 3 && a == 0 && pp == 0) dbg_flag(F, 16u);
            } } }
}
#endif
constexpr int N_PHASES = 1 + NLAYER * 9 + 1;
struct Args { const float* in[28]; float* out; unsigned char* ws; int ph_lo, ph_hi; };
__global__ void __launch_bounds__(NWAVES * 64, 2) hyb_fwd(Args args) {
    extern __shared__ __attribute__((aligned(16))) unsigned char lds[];
    Frame F;
    F.lds = (LAS unsigned char*)lds;
    F.MISC = (volatile LAS unsigned*)(F.lds + MISC_OFF);
    const int wave0 = __builtin_amdgcn_readfirstlane((int)threadIdx.x >> 6);
#define MAKE_TID() ((wave0 << 6) | lane_now())
    F.tid = MAKE_TID(); F.lane = F.tid & 63; F.wave = wave0;
    F.G = gridDim.x; { const int bx = blockIdx.x; F.vcu = (F.G % 8 == 0) ? (bx % 8) * (F.G / 8) + bx / 8 : bx; }
    const int vcu0 = F.vcu, grid0 = F.G, bx0 = blockIdx.x; F.bx = bx0;
    F.out = args.out; F.ws = args.ws; F.ctl = (gu32*)(args.ws + WS_CTL);
    for (int u = F.tid; u < (LDS_BYTES - LDSCTL_OFF) / 4; u += NWAVES * 64) ((LAS unsigned*)(F.lds + LDSCTL_OFF))[u] = 0u;
    __syncthreads();
    if (F.tid == 0) {
#pragma unroll
        for (int i = 0; i < 28; ++i) { const unsigned long long pv = (unsigned long long)args.in[i]; LAS unsigned* p = (LAS unsigned*)(F.lds + LDSCTL_OFF) + 2 * i; p[0] = (unsigned)pv; p[1] = (unsigned)(pv >> 32); }
    }
    __syncthreads();
    XcdBarrier bar = xcd_barrier_post((unsigned*)(F.ctl + CW_BAR), F.MISC + 8, F.tid == 0);
    const int lo = args.ph_lo, hi = args.ph_hi; int ph = 0;
#define PH_BEGIN if (ph >= lo && ph < hi) { { int t_ = MAKE_TID(); asm volatile("" : "+v"(t_)); F.tid = t_; F.lane = t_ & 63; F.wave = wave0; GAS unsigned char* w_ = (GAS unsigned char*)args.ws; asm volatile("" : "+s"(w_)); F.ws = (unsigned char*)w_; F.ctl = (gu32*)(w_ + WS_CTL); int v_ = vcu0, g_ = grid0, b_ = bx0; asm volatile("" : "+s"(v_), "+s"(g_), "+s"(b_)); F.vcu = v_; F.G = g_; F.bx = b_; LAS unsigned char* l_ = (LAS unsigned char*)lds; asm volatile("" : "+s"(l_)); F.lds = l_; F.MISC = (volatile LAS unsigned*)(l_ + MISC_OFF); }
#define PH_END   if (ph + 1 < hi) { int t2_ = MAKE_TID(); asm volatile("" : "+v"(t2_)); xcd_barrier(bar, t2_ == 0); } } ++ph;
    PG8_LAS unsigned char* ring = (PG8_LAS unsigned char*)(F.lds + RING_OFF);

    PH_BEGIN p0_prologue(F); phase_n1(F, 0); PH_END

    for (int L = 0; L < NLAYER; ++L) {
        const int kind = L % 3, slot = L / 3;
        const int nin = (kind == 0) ? 2048 : (kind == 1 ? 5120 : 4608);
        const size_t win_off = (L == 0) ? WS_WIN0 : (L == 1 ? WS_WIN1 : (L == 2 ? WS_WIN2 : WS_WIN3));
        PH_BEGIN if (L > 0) phase_n1(F, L); PH_END
        PH_BEGIN {
#if DBG_CHECKS
            if (F.bx == F.G - 1 && F.wave == 0) { if (L == 0) { const float s2 = wave_sum((float)F.lane); if (__any(s2 != 2016.f) && F.lane == 0) dbg_flag(F, 16u); dbg_check_hx(F, 0, 1u); }
                if (L == 1) dbg_check_hx(F, 1, 2u); if (L == 2) dbg_check_hx(F, 2, 4u); if (L == 3) dbg_check_hx(F, 3, 8u); }
#endif
            pg8::Gemm g{WSP(pg8::bf16_t, WS_H), (const pg8::bf16_t*)(F.ws + win_off), T, nin, DM};
            G1Order S; S.so.init(T, nin, 1, 0); S.nin = (T / 256) * (nin / 256); S.nextra = (L == 0) ? 64 : 0; S.G = F.G; S.c = F.bx; S.rope_tiles = (kind == 1) ? 12 : 0;
            pg8::EpiStore<true, false> E{WSP(pg8::bf16_t, WS_BIG), nin, WSP(pg8::bf16_t, WS_MEMKV), 1024, nullptr, WSP(float, WS_COS), WSP(float, WS_SIN)};
            pg8::gemm_phase<pg8::EpiStore<true, false>, G1Order, true, true>(ring, g, S, E, F.tid);
        } PH_END
        PH_BEGIN {
            if (kind == 0) phase_pool_prep(F);
            if (kind == 2) { for (int it = F.bx; it < BATCH * 24; it += F.G) ssd_scan_item(F, it); }
#if DBG_CHECKS
#endif
            phase_attn(F, L, (kind == 1) ? 768 : 0, nin, (char*)lds + RING_OFF);
        } PH_END
        PH_BEGIN {
            if (L == ABL_NOMIX) abl_zero_mix(F); else {
            if (kind == 0) {
                int kk_ = 384; asm volatile("" : "+s"(kk_));
                pg8::Gemm g{WSP(pg8::bf16_t, WS_MIX), WSP(pg8::bf16_t, WS_WGRP) + (size_t)slot * 4 * 512 * 384, 4 * T, 2048, kk_};
                PoolOrder S{F.G, F.bx};
                pg8::EpiStore<false, false> E{WSP(pg8::bf16_t, WS_CONCAT), 2048, nullptr, 0, nullptr, nullptr, nullptr};
                pg8::gemm_phase<pg8::EpiStore<false, false>, PoolOrder, true, true>(ring, g, S, E, F.tid);
            }
            if (kind == 1) phase_diff_combine(F, L);
            if (kind == 2) phase_ssd_norm(F);
#if DBG_CHECKS
#endif
            }
        } PH_END
        PH_BEGIN {
            pg8::Gemm g{WSP(pg8::bf16_t, WS_CONCAT), WSP(pg8::bf16_t, WS_WOUT) + (size_t)L * DM * DM, T, DM, DM};
            PlainOrder S; S.so.init(T, DM, F.G, F.bx);
            pg8::EpiResid E{WSP(float, WS_X), DM};
            pg8::gemm_phase<pg8::EpiResid, PlainOrder, true, true>(ring, g, S, E, F.tid);
        } PH_END
        PH_BEGIN phase_n2(F, L); PH_END
        PH_BEGIN phase_s1(F, L); PH_END
        PH_BEGIN {
            const int mt = moe_build_pref(F, L);
            pg8::Gemm g{WSP(pg8::bf16_t, WS_BIG), WSP(pg8::bf16_t, WS_WGU) + (size_t)L * 16 * 1024 * DM, SLOTS, 16 * 1024, DM};
            MoeOrder S{(volatile LAS int*)(F.MISC + 16), 4, 128, mt * 4, F.G, F.bx};
            pg8::EpiSwiglu E{WSP(pg8::bf16_t, WS_HIDS), DE, WSP(float, WS_GWS)};
            pg8::gemm_phase<pg8::EpiSwiglu, MoeOrder, true, true>(ring, g, S, E, F.tid);
        } PH_END
        PH_BEGIN {
            const int mt = moe_build_pref(F, L);
            pg8::Gemm g{WSP(pg8::bf16_t, WS_HIDS), WSP(pg8::bf16_t, WS_WD) + (size_t)L * 16 * DM * DE, SLOTS, 16 * DM, DE};
            MoeOrder S{(volatile LAS int*)(F.MISC + 16), 8, 256, mt * 8, F.G, F.bx};
            pg8::EpiStore<false, false> E{WSP(pg8::bf16_t, WS_BIG), DM, nullptr, 0, nullptr, nullptr, nullptr};
            pg8::gemm_phase<pg8::EpiStore<false, false>, MoeOrder, true, true>(ring, g, S, E, F.tid);
        } PH_END
    }
    PH_BEGIN phase_final(F); PH_END
#undef PH_BEGIN
#undef PH_END
}

#ifndef MK_PER_PHASE
#define MK_PER_PHASE 0
#endif
extern "C" void kernel_launch(void* const* d_in, const int* in_sizes, int n_in, void* d_out, int out_size, void* d_ws, size_t ws_size, hipStream_t stream) {
    static int grid = 0;
    if (grid == 0) {
        if (n_in != 28 || in_sizes[0] != T * DM || out_size != T * DM || ws_size < WS_END) {
            fprintf(stderr, "kernel_launch: built for 28 inputs, x/out of %d floats, >= %zu bytes of workspace; got n_in %d, in0 %d, out %d, ws %zu; nothing launched\n", T * DM, (size_t)WS_END, n_in, n_in > 0 ? in_sizes[0] : -1, out_size, ws_size);
            grid = -1; return; }
        int dev = 0, cus = 0, per_cu = 0;
        if (hipGetDevice(&dev) != hipSuccess || hipDeviceGetAttribute(&cus, hipDeviceAttributeMultiprocessorCount, dev) != hipSuccess) { fprintf(stderr, "kernel_launch: device query failed\n"); grid = -1; return; }
        if (hipFuncSetAttribute((const void*)hyb_fwd, hipFuncAttributeMaxDynamicSharedMemorySize, LDS_BYTES) != hipSuccess) { fprintf(stderr, "kernel_launch: hipFuncSetAttribute failed\n"); grid = -1; return; }
        if (hipOccupancyMaxActiveBlocksPerMultiprocessor(&per_cu, (const void*)hyb_fwd, NWAVES * 64, LDS_BYTES) != hipSuccess || per_cu < 1)
            fprintf(stderr, "kernel_launch: note: occupancy query reports %d workgroups per CU\n", per_cu);
        (void)hipGetLastError();
        grid = cus;
    }
    if (grid < 0) return;
    if (hipMemsetAsync((char*)d_ws + WS_CTL, 0, CTL_ZERO_BYTES, stream) != hipSuccess) { fprintf(stderr, "kernel_launch: memset failed\n"); return; }
    Args a{};
    for (int i = 0; i < 28; ++i) a.in[i] = (const float*)d_in[i];
    a.out = (float*)d_out; a.ws = (unsigned char*)d_ws;
#if MK_PER_PHASE
    for (int p = 0; p < N_PHASES; ++p) { a.ph_lo = p; a.ph_hi = p + 1; hipLaunchKernelGGL(hyb_fwd, dim3(grid), dim3(NWAVES * 64), LDS_BYTES, stream, a); }
#else
#ifndef MK_PH_HI
#define MK_PH_HI N_PHASES
#endif
    a.ph_lo = 0; a.ph_hi = MK_PH_HI;
    hipLaunchKernelGGL(hyb_fwd, dim3(grid), dim3(NWAVES * 64), LDS_BYTES, stream, a);
#endif
    const hipError_t le = hipPeekAtLastError();
    if (le != hipSuccess) fprintf(stderr, "kernel_launch: launch failed: %s\n", hipGetErrorName(le));
}
```
